# Optimizing an MI355X kernel written in HIP

```python
import math
import jax
import jax.numpy as jnp
from jax import lax
import numpy as np

D_MODEL = 2048
BATCH = 4
SEQ = 2048
DEPTH = 4

GRID_W = 64
CTX_LEN = 256
N_EVEN = (DEPTH + 1) // 2
N_ODD = DEPTH // 2
EPS = 1e-6

BRANCH = D_MODEL // 2
S5_GROUP = 16
S5_GROUPS = BRANCH // S5_GROUP
S5_STATE = 64
S5_DT_MIN = 1e-3
S5_DT_MAX = 1e-1
DA_HEAD = 64
DA_HEADS = BRANCH // (2 * DA_HEAD)
DA_VDIM = 2 * DA_HEAD
Q_BLOCK = 128
ROPE_BASE = 10000.0
GLA_HEADS = 4
GLA_KEY = D_MODEL // 2
GLA_VAL = D_MODEL
GLA_DK = GLA_KEY // GLA_HEADS
GLA_DV = GLA_VAL // GLA_HEADS
GLA_RANK = 16
GLA_TAU = 16.0
GLA_CHUNK = 64

kernel_name = "hybrid_s5_diffattn_gla_prefix_dit"


def rms_norm(x, g):
    xf = x.astype(jnp.float32)
    xf = xf * lax.rsqrt(jnp.mean(xf * xf, axis=-1, keepdims=True) + EPS)
    return (xf * g.astype(jnp.float32)).astype(x.dtype)


def modulation(cond, w, b, n_chunks):
    width = n_chunks * D_MODEL
    m = jax.nn.silu(cond) @ w[:, :width] + b[:width]
    return jnp.split(m, n_chunks, axis=-1)


def modulate(x, g, shift, scale):
    return rms_norm(x, g) * (1 + scale) + shift


def _flip(t, axis, on):
    return jnp.flip(t, axis=axis) if on else t


def axial_rope(n_tokens):
    rows = n_tokens // GRID_W
    row = jnp.repeat(jnp.arange(rows, dtype=jnp.float32), GRID_W)
    col = jnp.tile(jnp.arange(GRID_W, dtype=jnp.float32), rows)
    n_freq = DA_HEAD // 4
    inv_freq = ROPE_BASE ** (-jnp.arange(n_freq, dtype=jnp.float32) / n_freq)
    ang_r = row[:, None] * inv_freq
    ang_c = col[:, None] * inv_freq
    ang = jnp.concatenate([ang_r, ang_r, ang_c, ang_c], axis=-1)
    return jnp.cos(ang), jnp.sin(ang)


def apply_rope(x, cos, sin):
    a, b, c_, d = jnp.split(x, 4, axis=-1)
    rot = jnp.concatenate([-b, a, -d, c_], axis=-1)
    cos = cos[:, None, None, :].astype(x.dtype)
    sin = sin[:, None, None, :].astype(x.dtype)
    return x * cos + rot * sin


def _diff_block(qb, keys, vals, lam):
    s = jnp.einsum("bqhme,bkhme->bhmqk", qb, keys).astype(jnp.float32) * (DA_HEAD ** -0.5)
    p = jax.nn.softmax(s, axis=-1)
    w = p[:, :, 0] - lam * p[:, :, 1]
    return jnp.einsum("bhqk,bkhv->bqhv", w.astype(vals.dtype), vals)


def diff_attention(q_lat, k_lat, v_lat, q_ctx, k_ctx, v_ctx, qn_g, kn_g, lam_vecs, subln_g, lam_init):
    B, L, _ = q_lat.shape

    def heads_qk(t, g):
        return rms_norm(t.reshape(t.shape[0], t.shape[1], DA_HEADS, 2, DA_HEAD), g)

    def heads_v(t):
        return t.reshape(t.shape[0], t.shape[1], DA_HEADS, DA_VDIM)

    cos, sin = axial_rope(L)
    q = apply_rope(heads_qk(q_lat, qn_g), cos, sin)
    k = apply_rope(heads_qk(k_lat, kn_g), cos, sin)
    kc = heads_qk(k_ctx, kn_g)
    vc = heads_v(v_ctx)
    keys = jnp.concatenate([kc, k], axis=1)
    vals = jnp.concatenate([vc, heads_v(v_lat)], axis=1)
    lv = lam_vecs.astype(jnp.float32)
    lam = jnp.exp(jnp.sum(lv[0] * lv[1])) - jnp.exp(jnp.sum(lv[2] * lv[3])) + lam_init
    nb = L // Q_BLOCK
    qb = q.reshape(B, nb, Q_BLOCK, DA_HEADS, 2, DA_HEAD).swapaxes(0, 1)
    o = lax.map(lambda blk: _diff_block(blk, keys, vals, lam), qb)
    o = o.swapaxes(0, 1).reshape(B, L, DA_HEADS, DA_VDIM)

    def finish(t):
        t = rms_norm(t, subln_g) * (1 - lam_init)
        return t.reshape(t.shape[0], t.shape[1], BRANCH)

    y_lat = finish(o)
    y_ctx = None
    if q_ctx is not None:
        qc = heads_qk(q_ctx, qn_g)
        y_ctx = finish(_diff_block(qc, kc, vc, lam))
    return y_lat, y_ctx


def s5_discretize(a_re, a_im, log_dt, b_re, b_im):
    a_re, a_im = a_re.astype(jnp.float32), a_im.astype(jnp.float32)
    b_re, b_im = b_re.astype(jnp.float32), b_im.astype(jnp.float32)
    dt = jnp.exp(log_dt.astype(jnp.float32))[:, None]
    mag = jnp.exp(a_re * dt)
    ang = a_im * dt
    lb_re, lb_im = mag * jnp.cos(ang), mag * jnp.sin(ang)
    nr, ni = lb_re - 1.0, lb_im
    den = a_re * a_re + a_im * a_im
    f_re = (nr * a_re + ni * a_im) / den
    f_im = (ni * a_re - nr * a_im) / den
    bb_re = f_re[..., None] * b_re - f_im[..., None] * b_im
    bb_im = f_re[..., None] * b_im + f_im[..., None] * b_re
    return lb_re, lb_im, bb_re, bb_im


def _s5_combine(e1, e2):
    ar1, ai1, br1, bi1 = e1
    ar2, ai2, br2, bi2 = e2
    return (ar1 * ar2 - ai1 * ai2, ar1 * ai2 + ai1 * ar2,
            ar2 * br1 - ai2 * bi1 + br2, ar2 * bi1 + ai2 * br1 + bi2)


def s5_scan(u, h0_re, h0_im, lb_re, lb_im, bb_re, bb_im):
    bu_re = jnp.einsum("bngc,gpc->bngp", u, bb_re)
    bu_im = jnp.einsum("bngc,gpc->bngp", u, bb_im)
    bu_re = bu_re.at[:, 0].add(lb_re * h0_re - lb_im * h0_im)
    bu_im = bu_im.at[:, 0].add(lb_re * h0_im + lb_im * h0_re)
    a_re = jnp.broadcast_to(lb_re, bu_re.shape)
    a_im = jnp.broadcast_to(lb_im, bu_im.shape)
    _, _, h_re, h_im = lax.associative_scan(_s5_combine, (a_re, a_im, bu_re, bu_im), axis=1)
    return h_re, h_im


def s5_readout(h_re, h_im, c_re, c_im):
    return jnp.einsum("bngp,gcp->bngc", h_re, c_re) - jnp.einsum("bngp,gcp->bngc", h_im, c_im)


def s5_mixer(u_lat, u_ctx, a_re, a_im, log_dt, b_re, b_im, c_re, c_im, d_skip, w_glu, with_ctx_out):
    dtype = u_lat.dtype

    def grp(u):
        return u.astype(jnp.float32).reshape(u.shape[0], u.shape[1], S5_GROUPS, S5_GROUP)

    ul, uc = grp(u_lat), grp(u_ctx)
    zero = jnp.zeros((ul.shape[0], S5_GROUPS, S5_STATE), jnp.float32)
    ys_lat, ys_ctx = [], []
    for d in range(2):
        rev = d == 1
        lb_re, lb_im, bb_re, bb_im = s5_discretize(a_re[d], a_im[d], log_dt[d], b_re[d], b_im[d])
        cr, ci = c_re[d].astype(jnp.float32), c_im[d].astype(jnp.float32)
        hc_re, hc_im = s5_scan(_flip(uc, 1, rev), zero, zero, lb_re, lb_im, bb_re, bb_im)
        hl_re, hl_im = s5_scan(_flip(ul, 1, rev), hc_re[:, -1], hc_im[:, -1], lb_re, lb_im, bb_re, bb_im)
        ys_lat.append(_flip(s5_readout(hl_re, hl_im, cr, ci), 1, rev))
        if with_ctx_out:
            ys_ctx.append(_flip(s5_readout(hc_re, hc_im, cr, ci), 1, rev))
    dg = d_skip.astype(jnp.float32).reshape(S5_GROUPS, S5_GROUP)
    wg = w_glu.astype(jnp.float32)

    def finish(y, u):
        y = (y + dg * u).reshape(u.shape[0], u.shape[1], BRANCH)
        g = jax.nn.gelu(y)
        return (g * jax.nn.sigmoid(g @ wg)).astype(dtype)

    y_lat = finish(ys_lat[0] + ys_lat[1], ul)
    y_ctx = finish(ys_ctx[0] + ys_ctx[1], uc) if with_ctx_out else None
    return y_lat, y_ctx


def gla_chunk_scan(q, k, v, log_a, s0):
    B, H, N, _ = k.shape
    nc = N // GLA_CHUNK

    def chunks(t):
        return t.reshape(B, H, nc, GLA_CHUNK, t.shape[-1]).transpose(2, 0, 1, 3, 4)

    upto = jnp.tril(jnp.ones((GLA_CHUNK, GLA_CHUNK), dtype=bool))

    def step(s, inp):
        kk, vv, aa = inp[0], inp[1], inp[2]
        b = jnp.cumsum(aa, axis=2)
        b_end = b[:, :, -1:, :]
        s_new = (jnp.exp(b_end[:, :, 0, :, None]) * s
                 + jnp.einsum("bhsd,bhsv->bhdv", kk * jnp.exp(b_end - b), vv))
        if q is None:
            return s_new, None
        q_dec = inp[3] * jnp.exp(b)
        scores = jnp.where(upto, jnp.einsum("bhtd,bhsd->bhts", q_dec, kk * jnp.exp(-b)), 0.0)
        o = jnp.einsum("bhts,bhsv->bhtv", scores, vv) + jnp.einsum("bhtd,bhdv->bhtv", q_dec, s)
        return s_new, o

    xs = [chunks(k), chunks(v), chunks(log_a)]
    if q is not None:
        xs.append(chunks(q))
    s_fin, o = lax.scan(step, s0, tuple(xs))
    if q is not None:
        o = o.transpose(1, 2, 0, 3, 4).reshape(B, H, N, v.shape[-1])
    return o, s_fin


def _gla_heads(t, dh):
    return t.astype(jnp.float32).reshape(t.shape[0], t.shape[1], GLA_HEADS, dh).transpose(0, 2, 1, 3)


def _gla_log_decay(h, wa1, wa2, ba):
    logits = ((h @ wa1) @ wa2 + ba).astype(jnp.float32)
    return _gla_heads(jax.nn.log_sigmoid(logits), GLA_DK) / GLA_TAU


def _gla_out(o, g, dtype):
    o = rms_norm(o.transpose(0, 2, 1, 3), g)
    return o.reshape(o.shape[0], o.shape[1], GLA_VAL).astype(dtype)


def gla_mixer(h_lat, h_ctx, q_lat, k_lat, v_lat, q_ctx, k_ctx, v_ctx, wa1, wa2, ba, norm_g):
    dtype = v_lat.dtype
    scale = GLA_DK ** -0.5
    ql = _gla_heads(q_lat, GLA_DK) * scale
    kl, vl = _gla_heads(k_lat, GLA_DK), _gla_heads(v_lat, GLA_DV)
    kc, vc = _gla_heads(k_ctx, GLA_DK), _gla_heads(v_ctx, GLA_DV)
    qc = None if q_ctx is None else _gla_heads(q_ctx, GLA_DK) * scale
    s0 = jnp.zeros((kl.shape[0], GLA_HEADS, GLA_DK, GLA_DV), jnp.float32)
    outs_lat, outs_ctx = [], []
    for d in range(2):
        rev = d == 1
        al = _flip(_gla_log_decay(h_lat, wa1[d], wa2[d], ba[d]), 2, rev)
        ac = _flip(_gla_log_decay(h_ctx, wa1[d], wa2[d], ba[d]), 2, rev)
        oc, s_ctx = gla_chunk_scan(None if qc is None else _flip(qc, 2, rev),
                                   _flip(kc, 2, rev), _flip(vc, 2, rev), ac, s0)
        ol, _ = gla_chunk_scan(_flip(ql, 2, rev), _flip(kl, 2, rev), _flip(vl, 2, rev), al, s_ctx)
        outs_lat.append(_flip(ol, 2, rev))
        if qc is not None:
            outs_ctx.append(_flip(oc, 2, rev))
    y_lat = _gla_out(outs_lat[0] + outs_lat[1], norm_g, dtype)
    y_ctx = None if qc is None else _gla_out(outs_ctx[0] + outs_ctx[1], norm_g, dtype)
    return y_lat, y_ctx


def _merge_even(s5_out, zs, da_out, zd, w_out):
    return jnp.concatenate([s5_out * jax.nn.silu(zs), da_out * jax.nn.silu(zd)], axis=-1) @ w_out


def even_layer(x_lat, x_ctx, c, c_ctx, ada_w, ada_b, norm_g, w_in, w_out,
               a_re, a_im, log_dt, b_re, b_im, c_re, c_im, d_skip, w_glu,
               qn_g, kn_g, lam_vecs, subln_g, lam_init, with_ctx_out):
    shift, scale, gate = modulation(c[:, None, :], ada_w, ada_b, 3)
    h_lat = modulate(x_lat, norm_g, shift, scale)
    u_l, zs_l, q_l, k_l, v_l, zd_l = jnp.split(h_lat @ w_in, 6, axis=-1)
    mod_c = modulation(c_ctx, ada_w, ada_b, 3 if with_ctx_out else 2)
    h_ctx = modulate(x_ctx, norm_g, mod_c[0], mod_c[1])
    if with_ctx_out:
        u_c, zs_c, q_c, k_c, v_c, zd_c = jnp.split(h_ctx @ w_in, 6, axis=-1)
    else:
        q_c = None
        u_c = h_ctx @ w_in[:, 0:BRANCH]
        k_c = h_ctx @ w_in[:, 3 * BRANCH:4 * BRANCH]
        v_c = h_ctx @ w_in[:, 4 * BRANCH:5 * BRANCH]
    s5_l, s5_c = s5_mixer(u_l, u_c, a_re, a_im, log_dt, b_re, b_im, c_re, c_im, d_skip, w_glu, with_ctx_out)
    da_l, da_c = diff_attention(q_l, k_l, v_l, q_c, k_c, v_c, qn_g, kn_g, lam_vecs, subln_g, lam_init)
    x_lat = x_lat + gate * _merge_even(s5_l, zs_l, da_l, zd_l, w_out)
    if with_ctx_out:
        x_ctx = x_ctx + mod_c[2] * _merge_even(s5_c, zs_c, da_c, zd_c, w_out)
    return x_lat, x_ctx


def odd_layer(x_lat, x_ctx, c, c_ctx, ada_w, ada_b, norm_g, w_in, w_out,
              wa1, wa2, ba, gla_norm_g, with_ctx_out):
    shift, scale, gate = modulation(c[:, None, :], ada_w, ada_b, 3)
    h_lat = modulate(x_lat, norm_g, shift, scale)
    cuts = (GLA_KEY, 2 * GLA_KEY, 2 * GLA_KEY + GLA_VAL)
    q_l, k_l, v_l, z_l = jnp.split(h_lat @ w_in, cuts, axis=-1)
    mod_c = modulation(c_ctx, ada_w, ada_b, 3 if with_ctx_out else 2)
    h_ctx = modulate(x_ctx, norm_g, mod_c[0], mod_c[1])
    if with_ctx_out:
        q_c, k_c, v_c, z_c = jnp.split(h_ctx @ w_in, cuts, axis=-1)
    else:
        q_c = None
        k_c = h_ctx @ w_in[:, cuts[0]:cuts[1]]
        v_c = h_ctx @ w_in[:, cuts[1]:cuts[2]]
    y_l, y_c = gla_mixer(h_lat, h_ctx, q_l, k_l, v_l, q_c, k_c, v_c, wa1, wa2, ba, gla_norm_g)
    x_lat = x_lat + gate * ((y_l * jax.nn.silu(z_l)) @ w_out)
    if with_ctx_out:
        x_ctx = x_ctx + mod_c[2] * ((y_c * jax.nn.silu(z_c)) @ w_out)
    return x_lat, x_ctx


def setup_inputs(seed: int = 0) -> dict:
    key = jax.random.key(seed)
    ks = iter(jax.random.split(key, 40))
    f32 = jnp.float32
    D = D_MODEL

    def nrm(shape, scale):
        return jax.random.normal(next(ks), shape, f32) * scale

    n_idx = jnp.arange(S5_STATE, dtype=f32)
    s5_shape = (N_EVEN, 2, S5_GROUPS, S5_STATE)
    return {
        "x": nrm((BATCH, SEQ, D), 1.0),
        "c": nrm((BATCH, D), 1.0),
        "ctx": nrm((BATCH, CTX_LEN, D), 1.0),
        "c_ctx": nrm((D,), 1.0),
        "ada_w": nrm((DEPTH, D, 3 * D), 0.2 * D ** -0.5),
        "ada_b": nrm((DEPTH, 3 * D), 0.01),
        "norm_g": 1.0 + nrm((DEPTH, D), 0.05),
        "ev_w_in": nrm((N_EVEN, D, 3 * D), D ** -0.5),
        "ev_w_out": nrm((N_EVEN, D, D), D ** -0.5),
        "s5_a_re": -0.5 + nrm(s5_shape, 0.01),
        "s5_a_im": math.pi * n_idx + nrm(s5_shape, 0.01),
        "s5_log_dt": jax.random.uniform(next(ks), (N_EVEN, 2, S5_GROUPS), f32,
                                        math.log(S5_DT_MIN), math.log(S5_DT_MAX)),
        "s5_b_re": nrm((N_EVEN, 2, S5_GROUPS, S5_STATE, S5_GROUP), (2 * S5_GROUP) ** -0.5),
        "s5_b_im": nrm((N_EVEN, 2, S5_GROUPS, S5_STATE, S5_GROUP), (2 * S5_GROUP) ** -0.5),
        "s5_c_re": nrm((N_EVEN, 2, S5_GROUPS, S5_GROUP, S5_STATE), 0.5 ** 0.5),
        "s5_c_im": nrm((N_EVEN, 2, S5_GROUPS, S5_GROUP, S5_STATE), 0.5 ** 0.5),
        "s5_d": nrm((N_EVEN, BRANCH), 1.0),
        "s5_w_glu": nrm((N_EVEN, BRANCH, BRANCH), BRANCH ** -0.5),
        "da_qn_g": 1.0 + nrm((N_EVEN, DA_HEAD), 0.05),
        "da_kn_g": 1.0 + nrm((N_EVEN, DA_HEAD), 0.05),
        "da_lam": nrm((N_EVEN, 4, DA_HEAD), 0.1),
        "da_subln_g": 1.0 + nrm((N_EVEN, DA_VDIM), 0.05),
        "od_w_in": nrm((N_ODD, D, 3 * D), D ** -0.5),
        "od_w_out": nrm((N_ODD, GLA_VAL, D), GLA_VAL ** -0.5),
        "gla_wa1": nrm((N_ODD, 2, D, GLA_RANK), D ** -0.5),
        "gla_wa2": nrm((N_ODD, 2, GLA_RANK, GLA_KEY), GLA_RANK ** -0.5),
        "gla_ba": nrm((N_ODD, 2, GLA_KEY), 0.1),
        "gla_norm_g": 1.0 + nrm((N_ODD, GLA_DV), 0.05),
    }


def reference(x, c, ctx, c_ctx, ada_w, ada_b, norm_g, ev_w_in, ev_w_out,
              s5_a_re, s5_a_im, s5_log_dt, s5_b_re, s5_b_im, s5_c_re, s5_c_im, s5_d, s5_w_glu,
              da_qn_g, da_kn_g, da_lam, da_subln_g,
              od_w_in, od_w_out, gla_wa1, gla_wa2, gla_ba, gla_norm_g):
    x_lat, x_ctx = x, ctx
    for i in range(DEPTH):
        j = i // 2
        with_ctx_out = i < DEPTH - 1
        if i % 2 == 0:
            lam_init = 0.8 - 0.6 * math.exp(-0.3 * i)
            x_lat, x_ctx = even_layer(
                x_lat, x_ctx, c, c_ctx, ada_w[i], ada_b[i], norm_g[i], ev_w_in[j], ev_w_out[j],
                s5_a_re[j], s5_a_im[j], s5_log_dt[j], s5_b_re[j], s5_b_im[j], s5_c_re[j], s5_c_im[j],
                s5_d[j], s5_w_glu[j], da_qn_g[j], da_kn_g[j], da_lam[j], da_subln_g[j],
                lam_init, with_ctx_out)
        else:
            x_lat, x_ctx = odd_layer(
                x_lat, x_ctx, c, c_ctx, ada_w[i], ada_b[i], norm_g[i], od_w_in[j], od_w_out[j],
                gla_wa1[j], gla_wa2[j], gla_ba[j], gla_norm_g[j], with_ctx_out)
    return x_lat
```

```cpp
#include <hip/hip_runtime.h>
#include <hip/hip_cooperative_groups.h>
#include <cstdio>
namespace cg = cooperative_groups;

__device__ __forceinline__ int tidx() { int t = threadIdx.x; asm volatile("" : "+v"(t)); return t; }
__device__ __forceinline__ int bidx() { int t = blockIdx.x; asm volatile("" : "+s"(t)); return t; }
__device__ __forceinline__ int gdim() { int t = gridDim.x; asm volatile("" : "+s"(t)); return t; }
namespace pg8 {
#define PG8_LAS __attribute__((address_space(3)))
typedef unsigned short bf16_t;
typedef short bf16x8 __attribute__((ext_vector_type(8)));
typedef float f32x4 __attribute__((ext_vector_type(4)));
typedef unsigned u32x4 __attribute__((ext_vector_type(4)));
constexpr int BM = 256, BK = 64, HALF = 128, HTB = HALF * BK * 2  , STAGE_BYTES = 8 * HTB, NXCD = 8, WGM = 8;

__host__ __device__ __forceinline__ int lds_byte(int r, int c) { const int st = (r >> 4) * 2 + (c >> 5), rr = r & 15, cc = c & 31, ob = rr * 64 + cc * 2; return st * 1024 + (ob ^ (((ob >> 9) & 1) << 5)); }
__host__ __device__ __forceinline__ void stage_rc(int b, int& R, int& C) { const int st = b / 1024, sb = b % 1024, swz = sb ^ (((sb >> 9) & 1) << 5); R = (st >> 1) * 16 + swz / 64; C = (st & 1) * 32 + (swz % 64) / 2; }
__host__ __device__ __forceinline__ int perm32(int rho) { const int n = rho >> 4, i = rho & 15; return 8 * (i >> 2) + 4 * n + (i & 3); }

struct Unit { int pm, pn; };
struct Gemm { const bf16_t* A; const bf16_t* Bt; int M, N, K; };

struct StaticOrder {
    int nM, nN, nwg, G, c;
    __host__ __device__ void init(int M, int N, int G_, int c_) { nM = M / BM; nN = N / BM; nwg = nM * nN; G = G_; c = c_; }
    __host__ __device__ bool next(int i, Unit& u) const {
        const long L = (long)i * G + c; if (L >= nwg) return false;
        int wgid = (int)L; { const int q = nwg / NXCD, r = nwg % NXCD, xcd = wgid % NXCD, off = wgid / NXCD; wgid = (xcd < r ? xcd * (q + 1) : r * (q + 1) + (xcd - r) * q) + off; }
        const int nig = WGM * nN, gid = wgid / nig, fm = gid * WGM, gsz = (nM - fm) < WGM ? (nM - fm) : WGM;
        u.pm = fm + ((wgid % nig) % gsz); u.pn = (wgid % nig) / gsz; return true;
    }
    __device__ __forceinline__ void a_ready(const Unit&) const {}
    __device__ __forceinline__ void done(const Unit&) const {}
};
__device__ __forceinline__ unsigned cvt_pk_bf16(float lo, float hi) { unsigned r; asm volatile("v_cvt_pk_bf16_f32 %0, %1, %2" : "=v"(r) : "v"(lo), "v"(hi)); return r; }
template <class Epi, class Sched, bool STAMP = false>
__device__ __forceinline__ void gemm_phase(PG8_LAS unsigned char* lds, const Gemm g, const Sched& S, const Epi& E, unsigned long long* stamps) {
    const int tid = tidx(), wid = __builtin_amdgcn_readfirstlane(tid >> 6), lane = tid & 63, wr = wid >> 2, wc = wid & 3, fr = lane & 15, fq = lane >> 4;
    const int K = g.K, nt = K / BK;
    int ts_lo = 0, ts_hi = 0, nts = 0; const unsigned long long rt_entry = STAMP ? (unsigned long long)wall_clock64() : 0ull;
#define PG8_STAMP() do { if (STAMP && wid == 0 && nts < 64) { const unsigned long long _c = (unsigned long long)clock64(); \
        ts_lo = (lane == nts) ? (int)(unsigned)_c : ts_lo; ts_hi = (lane == nts) ? (int)(unsigned)(_c >> 32) : ts_hi; ++nts; } } while (0)
    PG8_STAMP();
    unsigned voffA[2], voffB[2];
#pragma unroll
    for (int i = 0; i < 2; ++i) { int R, C; stage_rc(tid * 16 + i * 8192, R, C); const int Rb = Epi::PERM ? ((R & ~31) + perm32(R & 31)) : R;
        voffA[i] = (unsigned)(R * K + C) * 2u; voffB[i] = (unsigned)(Rb * K + C) * 2u; }
    const size_t kstep = (size_t)(BK * 2);
    const size_t hstep = (size_t)HALF * K * 2;
    const size_t tstep = 2 * hstep;
    const unsigned ldsw = (unsigned)wid * 1024u;
    const int aoff = lds_byte(wr * 64 + fr, fq * 8), boff = lds_byte(wc * 32 + fr, fq * 8);
#define PG8_SA(b, h) (((b) * 2 + (h)) * HTB)
#define PG8_SB(b, h) ((4 + (b) * 2 + (h)) * HTB)
#define PG8_STAGE(bufoff, gbase, voff) do { _Pragma("unroll") for (int _i = 0; _i < 2; ++_i) \
        __builtin_amdgcn_global_load_lds((const unsigned*)((const char*)(gbase) + (voff)[_i]), (PG8_LAS unsigned*)(lds + (bufoff) + ldsw + _i * 8192), 16, 0, 0); } while (0)
#define PG8_LDA(dst, b, h) do { _Pragma("unroll") for (int m = 0; m < 4; ++m) _Pragma("unroll") for (int k = 0; k < 2; ++k) dst[m][k] = *(const PG8_LAS bf16x8*)(lds + PG8_SA(b, h) + aoff + m * 2048 + k * 1024); } while (0)
#define PG8_LDB(dst, b, h) do { _Pragma("unroll") for (int n = 0; n < 2; ++n) _Pragma("unroll") for (int k = 0; k < 2; ++k) dst[n][k] = *(const PG8_LAS bf16x8*)(lds + PG8_SB(b, h) + boff + n * 2048 + k * 1024); } while (0)
#define PG8_MMA(ai, bj, At, Bt) do { __builtin_amdgcn_s_setprio(1); _Pragma("unroll") for (int m = 0; m < 4; ++m) _Pragma("unroll") for (int n = 0; n < 2; ++n) _Pragma("unroll") for (int k = 0; k < 2; ++k) \
        acc[ai][bj][m][n] = __builtin_amdgcn_mfma_f32_16x16x32_bf16(Bt[n][k], At[m][k], acc[ai][bj][m][n], 0, 0, 0); __builtin_amdgcn_s_setprio(0); } while (0)
#define PG8_WAIT_V(n) asm volatile("s_waitcnt vmcnt(" #n ")" ::: "memory")
#define PG8_WAIT_L(n) asm volatile("s_waitcnt lgkmcnt(" #n ")" ::: "memory")
#define PG8_BAR __builtin_amdgcn_s_barrier()
#define PG8_SCHED __builtin_amdgcn_sched_barrier(0)
    Unit cur, nxt; int ui = 0;
    if (!S.next(0, cur)) return;
    f32x4 acc[2][2][4][2];
#pragma unroll
    for (int a = 0; a < 2; ++a)
#pragma unroll
        for (int b = 0; b < 2; ++b)
#pragma unroll
            for (int m = 0; m < 4; ++m)
#pragma unroll
                for (int n = 0; n < 2; ++n) acc[a][b][m][n] = (f32x4){0.f, 0.f, 0.f, 0.f};
    bf16x8 At[4][2], B0[2][2], B1[2][2];
    const char* cA = (const char*)g.A + (size_t)cur.pm * tstep; const char* cB = (const char*)g.Bt + (size_t)cur.pn * tstep;
    S.a_ready(cur);
    PG8_STAGE(PG8_SB(0, 0), cB, voffB); PG8_STAGE(PG8_SA(0, 0), cA, voffA); PG8_STAGE(PG8_SB(0, 1), cB + hstep, voffB); PG8_STAGE(PG8_SA(0, 1), cA + hstep, voffA);
    if (wr == 1) PG8_BAR;
    PG8_WAIT_V(4); PG8_BAR;
    PG8_STAGE(PG8_SB(1, 0), cB + kstep, voffB); PG8_STAGE(PG8_SA(1, 0), cA + kstep, voffA); PG8_STAGE(PG8_SB(1, 1), cB + hstep + kstep, voffB);
    PG8_WAIT_V(6); PG8_BAR;
    PG8_STAMP();
    for (;;) {
        const bool has_next = S.next(ui + 1, nxt);
        const char* nA = has_next ? (const char*)g.A + (size_t)nxt.pm * tstep : cA; const char* nB = has_next ? (const char*)g.Bt + (size_t)nxt.pn * tstep : cB;
        for (int t = 0; t < nt; t += 2) {
            const bool last = (t == nt - 2);
            const char* a1 = cA + (size_t)(t + 1) * kstep;
            const char* a2 = last ? nA : cA + (size_t)(t + 2) * kstep; const char* b2 = last ? nB : cB + (size_t)(t + 2) * kstep;
            const char* a3 = a2 + kstep; const char* b3 = b2 + kstep;
            if (last && has_next) S.a_ready(nxt);
            PG8_LDB(B0, 0, 0); PG8_SCHED; PG8_LDA(At, 0, 0); PG8_STAGE(PG8_SA(1, 1), a1 + hstep, voffA);
            PG8_WAIT_L(8); PG8_BAR; PG8_WAIT_L(0); PG8_MMA(0, 0, At, B0); PG8_BAR; PG8_SCHED;
            PG8_LDB(B1, 0, 1); PG8_STAGE(PG8_SB(0, 0), b2, voffB);
            PG8_BAR; PG8_WAIT_L(0); PG8_MMA(0, 1, At, B1); PG8_BAR;
            PG8_LDA(At, 0, 1); PG8_STAGE(PG8_SA(0, 0), a2, voffA);
            PG8_BAR; PG8_WAIT_L(0); PG8_MMA(1, 0, At, B0); PG8_BAR; PG8_SCHED;
            PG8_STAGE(PG8_SB(0, 1), b2 + hstep, voffB);
            PG8_WAIT_V(6); PG8_BAR; PG8_MMA(1, 1, At, B1); PG8_BAR;
            PG8_LDB(B0, 1, 0); PG8_SCHED; PG8_LDA(At, 1, 0); PG8_STAGE(PG8_SA(0, 1), a2 + hstep, voffA);
            PG8_WAIT_L(8); PG8_BAR; PG8_WAIT_L(0); PG8_MMA(0, 0, At, B0); PG8_BAR; PG8_SCHED;
            PG8_LDB(B1, 1, 1); PG8_STAGE(PG8_SB(1, 0), b3, voffB);
            PG8_BAR; PG8_WAIT_L(0); PG8_MMA(0, 1, At, B1); PG8_BAR;
            PG8_LDA(At, 1, 1); PG8_STAGE(PG8_SA(1, 0), a3, voffA);
            PG8_BAR; PG8_WAIT_L(0); PG8_MMA(1, 0, At, B0); PG8_BAR; PG8_SCHED;
            PG8_STAGE(PG8_SB(1, 1), b3 + hstep, voffB);
            PG8_WAIT_V(6); PG8_BAR; PG8_MMA(1, 1, At, B1); PG8_BAR;
        }
        PG8_STAMP();
        if constexpr (!Epi::AFTER_DRAIN) { E(acc, cur, wr, wc, fr, fq); S.done(cur); }
        PG8_STAMP();
        if (!has_next) break;
#pragma unroll
        for (int a = 0; a < 2; ++a)
#pragma unroll
            for (int b = 0; b < 2; ++b)
#pragma unroll
                for (int m = 0; m < 4; ++m)
#pragma unroll
                    for (int n = 0; n < 2; ++n) acc[a][b][m][n] = (f32x4){0.f, 0.f, 0.f, 0.f};
        cur = nxt; cA = nA; cB = nB; ++ui;
    }
    PG8_WAIT_V(0);
    if (wr == 0) PG8_BAR;
    PG8_BAR;
    if constexpr (Epi::AFTER_DRAIN) { E.fused(acc, cur, wr, wc, fr, fq, lds, wid, lane); S.done(cur); }
    PG8_STAMP();
    if (STAMP && wid == 0) { stamps[lane] = lane < nts ? (((unsigned long long)(unsigned)ts_hi << 32) | (unsigned)ts_lo) : 0ull;
        if (lane == 62) stamps[62] = rt_entry; if (lane == 63) stamps[63] = (unsigned long long)wall_clock64(); }
#undef PG8_STAMP
#undef PG8_SA
#undef PG8_SB
#undef PG8_STAGE
#undef PG8_LDA
#undef PG8_LDB
#undef PG8_MMA
#undef PG8_WAIT_V
#undef PG8_WAIT_L
#undef PG8_BAR
#undef PG8_SCHED
}
}

using pg8::bf16_t; using pg8::bf16x8; using pg8::f32x4; using pg8::cvt_pk_bf16;
typedef float f32x16 __attribute__((ext_vector_type(16)));
typedef short bf16x4 __attribute__((ext_vector_type(4)));
typedef unsigned u32x2 __attribute__((ext_vector_type(2)));
typedef unsigned u32x4v __attribute__((ext_vector_type(4)));

constexpr int DM = 2048, NLAT = 8192, NROW = 9216, N1 = 6144, N1P = 6400;
constexpr size_t SZ_WTIN1 = (size_t)N1P * DM * 2, SZ_WTOUT1 = (size_t)DM * DM * 2, SZ_WTGLU1 = (size_t)1024 * 1024 * 2;
constexpr size_t OFF_WTIN = 0;
constexpr size_t OFF_WTOUT = OFF_WTIN + 4 * SZ_WTIN1;
constexpr size_t OFF_WTGLU = OFF_WTOUT + 4 * SZ_WTOUT1;
constexpr size_t OFF_MOD = OFF_WTGLU + 2 * SZ_WTGLU1;
constexpr size_t OFF_ROPE = OFF_MOD + (size_t)4 * 5 * 6144 * 4;
constexpr size_t OFF_H = OFF_ROPE + 8192;
constexpr size_t OFF_P1 = OFF_H + (size_t)NROW * DM * 2;
constexpr size_t OFF_XBUF = OFF_P1 + (size_t)NROW * N1 * 2;
constexpr size_t OFF_MERGED = OFF_XBUF + (size_t)NROW * DM * 4;
constexpr size_t OFF_VT = OFF_MERGED + (size_t)NROW * DM * 2;
constexpr size_t OFF_RBUF = OFF_VT + (size_t)NROW * DM * 2;
constexpr size_t OFF_DEC = OFF_RBUF + (size_t)NROW * 32 * 4;
constexpr size_t OFF_U = OFF_DEC + (size_t)2 * 144 * 1024 * 4;
constexpr size_t OFF_YBUF = OFF_U;
constexpr size_t OFF_GBUF = OFF_YBUF + (size_t)2 * NROW * 1024 * 4;
constexpr size_t OFF_QD = OFF_U;
constexpr size_t OFF_KD = OFF_QD + (size_t)2 * NROW * 1024 * 2;
constexpr size_t OFF_KET = OFF_KD + (size_t)2 * NROW * 1024 * 2;
constexpr size_t OFF_OBUF = OFF_KET + (size_t)2 * NROW * 1024 * 2;
constexpr size_t OFF_PARAMS = OFF_OBUF + (size_t)2 * NROW * DM * 4;
constexpr size_t WS_END = OFF_PARAMS + 1024 * 256;
constexpr int LDS_BYTES = 160 * 1024;

struct Params {
    const float *x, *c, *ctx, *c_ctx, *ada_w, *ada_b, *norm_g, *ev_w_in, *ev_w_out;
    const float *s5_a_re, *s5_a_im, *s5_log_dt, *s5_b_re, *s5_b_im, *s5_c_re, *s5_c_im, *s5_d, *s5_w_glu;
    const float *da_qn_g, *da_kn_g, *da_lam, *da_subln_g, *od_w_in, *od_w_out, *gla_wa1, *gla_wa2, *gla_ba, *gla_norm_g;
    float* out; unsigned char* ws;
    int ph_lo, ph_hi;
};

__device__ __forceinline__ float bf_lo(unsigned u) { return __uint_as_float(u << 16); }
__device__ __forceinline__ float bf_hi(unsigned u) { return __uint_as_float(u & 0xffff0000u); }
__device__ __forceinline__ float bf2f(bf16_t b) { return __uint_as_float(((unsigned)b) << 16); }
__device__ __forceinline__ bf16_t f2bf(float f) { return (bf16_t)(cvt_pk_bf16(f, 0.f) & 0xffffu); }
__device__ __forceinline__ f32x16 mfma32(bf16x8 a, bf16x8 b, f32x16 c) { return __builtin_amdgcn_mfma_f32_32x32x16_bf16(a, b, c, 0, 0, 0); }
__device__ __forceinline__ f32x4 mfma16(bf16x8 a, bf16x8 b, f32x4 c) { return __builtin_amdgcn_mfma_f32_16x16x32_bf16(a, b, c, 0, 0, 0); }
__device__ __forceinline__ float wave_sum(float v) {
#pragma unroll
    for (int o = 32; o > 0; o >>= 1) v += __shfl_xor(v, o);
    return v;
}
__device__ __forceinline__ bf16x8 pack8(float a0, float a1, float a2, float a3, float a4, float a5, float a6, float a7) {
    u32x4v u; u[0] = cvt_pk_bf16(a0, a1); u[1] = cvt_pk_bf16(a2, a3); u[2] = cvt_pk_bf16(a4, a5); u[3] = cvt_pk_bf16(a6, a7);
    return __builtin_bit_cast(bf16x8, u);
}
__device__ __forceinline__ float silu_f(float v) { return v / (1.f + __expf(-v)); }
__device__ __forceinline__ float sigmoid_f(float v) { return 1.f / (1.f + __expf(-v)); }
__device__ __forceinline__ void wave_lds_sync() { asm volatile("s_waitcnt lgkmcnt(0)" ::: "memory"); __builtin_amdgcn_wave_barrier(); }
typedef __attribute__((address_space(3))) unsigned char L8;
typedef __attribute__((address_space(3))) float LF;
typedef __attribute__((address_space(3))) unsigned short LB;
#define LV(T, ptr) (*(__attribute__((address_space(3))) T*)(ptr))
#define NOINL __forceinline__

__device__ __forceinline__ unsigned long long uni64(unsigned long long v) {
    const unsigned lo = (unsigned)__builtin_amdgcn_readfirstlane((int)(unsigned)v), hi = (unsigned)__builtin_amdgcn_readfirstlane((int)(unsigned)(v >> 32));
    return ((unsigned long long)hi << 32) | lo;
}
#define LAUNDER_S(x) asm volatile("" : "+s"(x))
__device__ __forceinline__ Params load_params(const Params* gp) {
    Params p = *gp;
    LAUNDER_S(p.x); LAUNDER_S(p.c); LAUNDER_S(p.ctx); LAUNDER_S(p.c_ctx); LAUNDER_S(p.ada_w); LAUNDER_S(p.ada_b); LAUNDER_S(p.norm_g); LAUNDER_S(p.ev_w_in); LAUNDER_S(p.ev_w_out);
    LAUNDER_S(p.s5_a_re); LAUNDER_S(p.s5_a_im); LAUNDER_S(p.s5_log_dt); LAUNDER_S(p.s5_b_re); LAUNDER_S(p.s5_b_im); LAUNDER_S(p.s5_c_re); LAUNDER_S(p.s5_c_im); LAUNDER_S(p.s5_d); LAUNDER_S(p.s5_w_glu);
    LAUNDER_S(p.da_qn_g); LAUNDER_S(p.da_kn_g); LAUNDER_S(p.da_lam); LAUNDER_S(p.da_subln_g); LAUNDER_S(p.od_w_in); LAUNDER_S(p.od_w_out); LAUNDER_S(p.gla_wa1); LAUNDER_S(p.gla_wa2); LAUNDER_S(p.gla_ba); LAUNDER_S(p.gla_norm_g);
    LAUNDER_S(p.out); LAUNDER_S(p.ws);
    return p;
}
__device__ __forceinline__ L8* uni_lds(L8* q) { return (L8*)(unsigned long long)(unsigned)__builtin_amdgcn_readfirstlane((int)(unsigned)(unsigned long long)q); }
#define PHASE_ENTRY const Params p = load_params(gp); LAUNDER_S(L)

__device__ NOINL void phase_prologue(const Params* gp, int L, L8* smem) {
    PHASE_ENTRY;
    const int tid = tidx();
    LF* lds = (LF*)smem;
    for (int t = bidx(); t < 16896; t += gdim()) {
        const float* W; bf16_t* Wt; int K, N, tk, tn;
        if (t < 12288) { const int L = t / 3072, rem = t % 3072; tk = rem / 96; tn = rem % 96; K = 2048; N = 6144;
            W = ((L & 1) ? p.od_w_in : p.ev_w_in) + (size_t)(L >> 1) * 2048 * 6144; Wt = (bf16_t*)(p.ws + OFF_WTIN + (size_t)L * SZ_WTIN1); }
        else if (t < 16384) { const int t2 = t - 12288, L = t2 / 1024, rem = t2 % 1024; tk = rem / 32; tn = rem % 32; K = 2048; N = 2048;
            W = ((L & 1) ? p.od_w_out : p.ev_w_out) + (size_t)(L >> 1) * 2048 * 2048; Wt = (bf16_t*)(p.ws + OFF_WTOUT + (size_t)L * SZ_WTOUT1); }
        else { const int t3 = t - 16384, j = t3 / 256, rem = t3 % 256; tk = rem / 16; tn = rem % 16; K = 1024; N = 1024;
            W = p.s5_w_glu + (size_t)j * 1024 * 1024; Wt = (bf16_t*)(p.ws + OFF_WTGLU + (size_t)j * SZ_WTGLU1); }
        {
            const int r = tid >> 3, c8 = (tid & 7) * 8;
            const float* src = W + (size_t)(tk * 64 + r) * N + tn * 64 + c8;
            const float4 a = *(const float4*)src, b = *(const float4*)(src + 4);
            LF* d = lds + r * 65 + c8;
            d[0] = a.x; d[1] = a.y; d[2] = a.z; d[3] = a.w; d[4] = b.x; d[5] = b.y; d[6] = b.z; d[7] = b.w;
        }
        __syncthreads();
        {
            const int n = tid >> 3, k8 = (tid & 7) * 8;
            const LF* s = lds + k8 * 65 + n;
            u32x4v o; o[0] = cvt_pk_bf16(s[0], s[65]); o[1] = cvt_pk_bf16(s[130], s[195]); o[2] = cvt_pk_bf16(s[260], s[325]); o[3] = cvt_pk_bf16(s[390], s[455]);
            *(u32x4v*)(Wt + (size_t)(tn * 64 + n) * K + tk * 64 + k8) = o;
        }
        __syncthreads();
    }
    for (int idx = bidx() * 512 + tid; idx < 2 * 256 * 2048; idx += gdim() * 512) {
        const int j = idx / (256 * 2048), rr = (idx / 2048) % 256, k = idx % 2048;
        float v = 0.f;
        if (rr < 32) { const int d = rr >> 4, n = rr & 15; v = p.gla_wa1[((size_t)(j * 2 + d) * 2048 + k) * 16 + n]; }
        bf16_t* Wt = (bf16_t*)(p.ws + OFF_WTIN + (size_t)(2 * j + 1) * SZ_WTIN1);
        Wt[(size_t)(6144 + rr) * 2048 + k] = f2bf(v);
    }
    if (bidx() == 0) {
        float* rope = (float*)(p.ws + OFF_ROPE);
        for (int idx = tid; idx < 1024; idx += 512) {
            const int pos = idx >> 4, i = idx & 15;
            const float inv = powf(10000.0f, -(float)i / 16.0f);
            const float ang = (float)pos * inv;
            rope[idx * 2] = cosf(ang); rope[idx * 2 + 1] = sinf(ang);
        }
    }
    __syncthreads();
    for (int i = tid; i < 5 * 2048; i += 512) { const int r = i >> 11, k = i & 2047; const float v = r < 4 ? p.c[r * 2048 + k] : p.c_ctx[k]; lds[i] = v / (1.f + expf(-v)); }
    __syncthreads();
    LF* red = lds + 5 * 2048;
    float* mod = (float*)(p.ws + OFF_MOD);
    for (int s = bidx(); s < 768; s += gdim()) {
        const int L = s / 192, n0 = (s % 192) * 32, col = tid & 31, ks = tid >> 5;
        const float* w = p.ada_w + (size_t)L * 2048 * 6144 + n0 + col;
        float a0 = 0.f, a1 = 0.f, a2 = 0.f, a3 = 0.f, a4 = 0.f;
#pragma unroll 8
        for (int k = ks; k < 2048; k += 16) {
            const float wv = w[(size_t)k * 6144];
            a0 += lds[k] * wv; a1 += lds[2048 + k] * wv; a2 += lds[4096 + k] * wv; a3 += lds[6144 + k] * wv; a4 += lds[8192 + k] * wv;
        }
        red[(ks * 5 + 0) * 32 + col] = a0; red[(ks * 5 + 1) * 32 + col] = a1; red[(ks * 5 + 2) * 32 + col] = a2; red[(ks * 5 + 3) * 32 + col] = a3; red[(ks * 5 + 4) * 32 + col] = a4;
        __syncthreads();
        if (tid < 160) {
            const int r = tid >> 5, c2 = tid & 31; float sum = 0.f;
#pragma unroll
            for (int q = 0; q < 16; ++q) sum += red[(q * 5 + r) * 32 + c2];
            mod[(size_t)(L * 5 + r) * 6144 + n0 + c2] = sum + p.ada_b[L * 6144 + n0 + c2];
        }
        __syncthreads();
    }
}

__device__ NOINL void phase_norm(const Params* gp, int L, L8* smem) {
    PHASE_ENTRY;
    const int wave = tidx() >> 6, lane = tidx() & 63;
    const float* g = p.norm_g + L * 2048;
    const float* xbuf = (const float*)(p.ws + OFF_XBUF);
    bf16_t* h = (bf16_t*)(p.ws + OFF_H);
    const float* mod = (const float*)(p.ws + OFF_MOD);
    for (int row = bidx() * 8 + wave; row < NROW; row += gdim() * 8) {
        const float* xr = (L == 0) ? (row < NLAT ? p.x + (size_t)row * 2048 : p.ctx + (size_t)(row - NLAT) * 2048) : xbuf + (size_t)row * 2048;
        const int mrow = row < NLAT ? (row >> 11) : 4;
        const float* md = mod + (size_t)(L * 5 + mrow) * 6144;
        float4 v[8]; float ss = 0.f;
#pragma unroll
        for (int i = 0; i < 8; ++i) { v[i] = *(const float4*)(xr + i * 256 + lane * 4); ss += v[i].x * v[i].x + v[i].y * v[i].y + v[i].z * v[i].z + v[i].w * v[i].w; }
        ss = wave_sum(ss);
        const float rstd = rsqrtf(ss * (1.f / 2048.f) + 1e-6f);
#pragma unroll
        for (int i = 0; i < 8; ++i) {
            const int c = i * 256 + lane * 4;
            const float4 gg = *(const float4*)(g + c), sh = *(const float4*)(md + c), sc = *(const float4*)(md + 2048 + c);
            const float o0 = (v[i].x * rstd * gg.x) * (1.f + sc.x) + sh.x, o1 = (v[i].y * rstd * gg.y) * (1.f + sc.y) + sh.y;
            const float o2 = (v[i].z * rstd * gg.z) * (1.f + sc.z) + sh.z, o3 = (v[i].w * rstd * gg.w) * (1.f + sc.w) + sh.w;
            u32x2 o; o[0] = cvt_pk_bf16(o0, o1); o[1] = cvt_pk_bf16(o2, o3);
            *(u32x2*)(h + (size_t)row * 2048 + c) = o;
        }
    }
}

struct EpiIn {
    static constexpr bool PERM = true, AFTER_DRAIN = false;
    bf16_t* P1; bf16_t* vT; float* rbuf; int odd;
    __device__ __forceinline__ void operator()(const f32x4 (&acc)[2][2][4][2], const pg8::Unit& u, int wr, int wc, int fr, int fq) const {
        const int row0 = u.pm * 256 + wr * 64 + fr, colt = u.pn * 256;
        const bool isr = colt >= 6144;
        const bool isv = odd ? (colt >= 2048 && colt < 4096) : (colt >= 4096 && colt < 5120);
        if (isr) {
            if (wc == 0) {
#pragma unroll
                for (int ai = 0; ai < 2; ++ai)
#pragma unroll
                    for (int m = 0; m < 4; ++m) { float* rp = rbuf + (size_t)(row0 + ai * 128 + m * 16) * 32 + 8 * fq;
                        *(f32x4*)rp = acc[ai][0][m][0]; *(f32x4*)(rp + 4) = acc[ai][0][m][1]; }
            }
        } else if (isv) {
#pragma unroll
            for (int ai = 0; ai < 2; ++ai)
#pragma unroll
                for (int m = 0; m < 4; ++m) {
                    const int row = row0 + ai * 128 + m * 16;
                    size_t base; int estride;
                    if (odd) { base = ((size_t)(row >> 6) * 2048) * 64 + (row & 63); estride = 64; }
                    else { int b, key; if (row < NLAT) { b = row >> 11; key = 256 + (row & 2047); } else { b = (row - NLAT) >> 8; key = (row - NLAT) & 255; }
                        base = (size_t)b * 8 * 128 * 2304 + key; estride = 2304; }
#pragma unroll
                    for (int bj = 0; bj < 2; ++bj)
#pragma unroll
                        for (int n = 0; n < 2; ++n)
#pragma unroll
                            for (int e = 0; e < 4; ++e) {
                                const int cv = (colt - (odd ? 2048 : 4096)) + bj * 128 + wc * 32 + 8 * fq + 4 * n + e;
                                vT[base + (size_t)cv * estride] = f2bf(acc[ai][bj][m][n][e]);
                            }
                }
        } else {
#pragma unroll
            for (int ai = 0; ai < 2; ++ai)
#pragma unroll
                for (int m = 0; m < 4; ++m) { bf16_t* rp = P1 + (size_t)(row0 + ai * 128 + m * 16) * N1 + colt + wc * 32 + 8 * fq;
#pragma unroll
                    for (int bj = 0; bj < 2; ++bj) { const f32x4 v0 = acc[ai][bj][m][0], v1 = acc[ai][bj][m][1];
                        u32x4v o; o[0] = cvt_pk_bf16(v0[0], v0[1]); o[1] = cvt_pk_bf16(v0[2], v0[3]); o[2] = cvt_pk_bf16(v1[0], v1[1]); o[3] = cvt_pk_bf16(v1[2], v1[3]);
                        *(u32x4v*)(rp + bj * 128) = o; } }
        }
    }
};
struct EpiGlu {
    static constexpr bool PERM = true, AFTER_DRAIN = false;
    const bf16_t* gbuf; const bf16_t* P1; bf16_t* merged;
    __device__ __forceinline__ void operator()(const f32x4 (&acc)[2][2][4][2], const pg8::Unit& u, int wr, int wc, int fr, int fq) const {
        const int row0 = u.pm * 256 + wr * 64 + fr, col0 = u.pn * 256 + wc * 32 + 8 * fq;
#pragma unroll
        for (int ai = 0; ai < 2; ++ai)
#pragma unroll
            for (int m = 0; m < 4; ++m) { const int row = row0 + ai * 128 + m * 16;
#pragma unroll
                for (int bj = 0; bj < 2; ++bj) { const int col = col0 + bj * 128;
                    const u32x4v g8 = *(const u32x4v*)(gbuf + (size_t)row * 1024 + col), z8 = *(const u32x4v*)(P1 + (size_t)row * N1 + 1024 + col);
                    u32x4v o;
#pragma unroll
                    for (int e = 0; e < 4; ++e) { const float a0 = acc[ai][bj][m][e >> 1][(e & 1) * 2], a1 = acc[ai][bj][m][e >> 1][(e & 1) * 2 + 1];
                        const float r0 = bf_lo(g8[e]) * sigmoid_f(a0) * silu_f(bf_lo(z8[e])), r1 = bf_hi(g8[e]) * sigmoid_f(a1) * silu_f(bf_hi(z8[e]));
                        o[e] = cvt_pk_bf16(r0, r1); }
                    *(u32x4v*)(merged + (size_t)row * 2048 + col) = o; } }
    }
};
struct EpiOut {
    static constexpr bool PERM = false, AFTER_DRAIN = false;
    const float* xin_lat; const float* xin_ctx; float* xout_lat; float* xout_ctx; const float* mod;
    __device__ __forceinline__ void operator()(const f32x4 (&acc)[2][2][4][2], const pg8::Unit& u, int wr, int wc, int fr, int fq) const {
        const int row0 = u.pm * 256 + wr * 64 + fr, col0 = u.pn * 256 + wc * 32 + 4 * fq;
        const int mrow = (u.pm < 32) ? (u.pm >> 3) : 4;
        const float* gp = mod + (size_t)mrow * 6144 + 4096 + col0;
        f32x4 gv[2][2];
#pragma unroll
        for (int bj = 0; bj < 2; ++bj)
#pragma unroll
            for (int n = 0; n < 2; ++n) gv[bj][n] = *(const f32x4*)(gp + bj * 128 + n * 16);
#pragma unroll
        for (int ai = 0; ai < 2; ++ai)
#pragma unroll
            for (int m = 0; m < 4; ++m) { const int row = row0 + ai * 128 + m * 16;
                const float* xi = (row < NLAT) ? xin_lat + (size_t)row * 2048 : xin_ctx + (size_t)(row - NLAT) * 2048;
                float* xo = (row < NLAT) ? xout_lat + (size_t)row * 2048 : xout_ctx + (size_t)(row - NLAT) * 2048;
#pragma unroll
                for (int bj = 0; bj < 2; ++bj)
#pragma unroll
                    for (int n = 0; n < 2; ++n) { const int c = col0 + bj * 128 + n * 16;
                        const f32x4 xv = *(const f32x4*)(xi + c);
                        *(f32x4*)(xo + c) = xv + gv[bj][n] * acc[ai][bj][m][n]; } }
    }
};

template <class Epi> __device__ __forceinline__ void run_gemm(L8* smem, const bf16_t* A, const bf16_t* Bt, int M, int N, int K, const Epi& E) {
    pg8::Gemm g{A, Bt, M, N, K};
    pg8::StaticOrder S; S.init(M, N, (int)gdim(), (int)bidx());
    pg8::gemm_phase<Epi, pg8::StaticOrder, false>(smem, g, S, E, nullptr);
    __syncthreads();
}

__device__ __forceinline__ void s5_stream(const Params& p, int j, int b, int g, int d, L8* lds) {
    const int lane = tidx() & 63, r = lane & 31, hh = lane >> 5, cn = lane & 15, q = lane >> 4;
    LF* BU = (LF*)lds;
    LB* Hs = (LB*)(lds + 64 * 132 * 4);
    const bf16_t* P1 = (const bf16_t*)(p.ws + OFF_P1);
    float* ybuf = (float*)(p.ws + OFF_YBUF);
    const int pd = (j * 2 + d) * 64 + g;
    const float are = p.s5_a_re[pd * 64 + lane], aim = p.s5_a_im[pd * 64 + lane];
    const float dt = expf(p.s5_log_dt[pd]);
    const float mag = expf(are * dt), ang = aim * dt;
    float sn, cs; sincosf(ang, &sn, &cs);
    const float lbr = mag * cs, lbi = mag * sn;
    const float nr = lbr - 1.f, ni = lbi, den = are * are + aim * aim;
    const float fre = (nr * are + ni * aim) / den, fim = (ni * are - nr * aim) / den;
    bf16x8 Bf[4];
#pragma unroll
    for (int nt = 0; nt < 4; ++nt) {
        const int ps = 32 * (nt & 1) + r;
        const float fr_ = __shfl(fre, ps), fi_ = __shfl(fim, ps);
        const float* bre = p.s5_b_re + ((size_t)pd * 64 + ps) * 16 + 8 * hh;
        const float* bim = p.s5_b_im + ((size_t)pd * 64 + ps) * 16 + 8 * hh;
        const float4 r0 = *(const float4*)bre, r1 = *(const float4*)(bre + 4), i0 = *(const float4*)bim, i1 = *(const float4*)(bim + 4);
        if ((nt >> 1) == 0)
            Bf[nt] = pack8(fr_ * r0.x - fi_ * i0.x, fr_ * r0.y - fi_ * i0.y, fr_ * r0.z - fi_ * i0.z, fr_ * r0.w - fi_ * i0.w,
                           fr_ * r1.x - fi_ * i1.x, fr_ * r1.y - fi_ * i1.y, fr_ * r1.z - fi_ * i1.z, fr_ * r1.w - fi_ * i1.w);
        else
            Bf[nt] = pack8(fr_ * i0.x + fi_ * r0.x, fr_ * i0.y + fi_ * r0.y, fr_ * i0.z + fi_ * r0.z, fr_ * i0.w + fi_ * r0.w,
                           fr_ * i1.x + fi_ * r1.x, fr_ * i1.y + fi_ * r1.y, fr_ * i1.z + fi_ * r1.z, fr_ * i1.w + fi_ * r1.w);
    }
    bf16x8 Cf[4];
#pragma unroll
    for (int ks = 0; ks < 4; ++ks) {
        const float* src = ((ks < 2) ? p.s5_c_re : p.s5_c_im) + ((size_t)pd * 16 + cn) * 64 + (ks & 1) * 32 + 8 * q;
        const float sg = (ks < 2) ? 1.f : -1.f;
        const float4 c0 = *(const float4*)src, c1 = *(const float4*)(src + 4);
        Cf[ks] = pack8(sg * c0.x, sg * c0.y, sg * c0.z, sg * c0.w, sg * c1.x, sg * c1.y, sg * c1.z, sg * c1.w);
    }
    float hre = 0.f, him = 0.f;
    for (int cq = 0; cq < 36; ++cq) {
        const int isctx = cq < 4, idx = isctx ? cq : cq - 4, nseg = isctx ? 4 : 32, cs_ = d ? (nseg - 1 - idx) : idx;
        const int rowbase = isctx ? (NLAT + b * 256 + cs_ * 64) : (b * 2048 + cs_ * 64);
#pragma unroll
        for (int mt = 0; mt < 2; ++mt) {
            const int s = 32 * mt + r, tok = d ? 63 - s : s;
            const bf16x8 A = *(const bf16x8*)(P1 + (size_t)(rowbase + tok) * N1 + g * 16 + 8 * hh);
#pragma unroll
            for (int nt = 0; nt < 4; ++nt) {
                f32x16 acc;
#pragma unroll
                for (int i = 0; i < 16; ++i) acc[i] = 0.f;
                acc = mfma32(A, Bf[nt], acc);
#pragma unroll
                for (int i = 0; i < 16; ++i) BU[(32 * mt + (i & 3) + 8 * (i >> 2) + 4 * hh) * 132 + 32 * nt + r] = acc[i];
            }
        }
        wave_lds_sync();
#pragma unroll 1
        for (int s0 = 0; s0 < 64; s0 += 16) {
            float br[16], bi[16];
#pragma unroll
            for (int k = 0; k < 16; ++k) { br[k] = BU[(s0 + k) * 132 + lane]; bi[k] = BU[(s0 + k) * 132 + 64 + lane]; }
#pragma unroll
            for (int k = 0; k < 16; ++k) {
                const float nre = lbr * hre - lbi * him + br[k], nim = lbr * him + lbi * hre + bi[k];
                hre = nre; him = nim;
                Hs[(s0 + k) * 136 + lane] = f2bf(hre); Hs[(s0 + k) * 136 + 64 + lane] = f2bf(him);
            }
        }
        wave_lds_sync();
#pragma unroll
        for (int mt = 0; mt < 4; ++mt) {
            f32x4 y = {0.f, 0.f, 0.f, 0.f};
#pragma unroll
            for (int ks = 0; ks < 4; ++ks) { const bf16x8 A = LV(const bf16x8, Hs + (16 * mt + cn) * 136 + 32 * ks + 8 * q); y = mfma16(A, Cf[ks], y); }
#pragma unroll
            for (int i = 0; i < 4; ++i) { const int s = 16 * mt + 4 * q + i, tok = d ? 63 - s : s;
                ybuf[((size_t)d * NROW + rowbase + tok) * 1024 + g * 16 + cn] = y[i]; }
        }
        wave_lds_sync();
    }
}

__device__ __forceinline__ void qk_norm_rope(const Params& p, int j, int wid, int nw) {
    const int lane = tidx() & 63, part = lane & 3;
    bf16_t* P1 = (bf16_t*)(p.ws + OFF_P1);
    const float* rope = (const float*)(p.ws + OFF_ROPE);
    for (int it = wid; it < NROW * 2; it += nw) {
        const int row = it >> 1, which = it & 1;
        bf16_t* ptr = P1 + (size_t)row * N1 + 2048 + which * 1024 + lane * 16;
        const u32x4v v0 = *(const u32x4v*)ptr, v1 = *(const u32x4v*)(ptr + 8);
        float x[16];
#pragma unroll
        for (int e = 0; e < 4; ++e) { x[2 * e] = bf_lo(v0[e]); x[2 * e + 1] = bf_hi(v0[e]); x[8 + 2 * e] = bf_lo(v1[e]); x[9 + 2 * e] = bf_hi(v1[e]); }
        float ss = 0.f;
#pragma unroll
        for (int i = 0; i < 16; ++i) ss += x[i] * x[i];
        ss += __shfl_xor(ss, 1); ss += __shfl_xor(ss, 2);
        const float rstd = rsqrtf(ss * (1.f / 64.f) + 1e-6f);
        const float* gn = (which ? p.da_kn_g : p.da_qn_g) + j * 64 + part * 16;
#pragma unroll
        for (int i = 0; i < 16; ++i) x[i] *= rstd * gn[i];
        if (row < NLAT) {
            const int t = row & 2047, pos = (part < 2) ? (t >> 6) : (t & 63);
            const float* rt = rope + pos * 32;
#pragma unroll
            for (int i = 0; i < 16; ++i) {
                const float px = __shfl_xor(x[i], 1), cs = rt[2 * i], sn = rt[2 * i + 1];
                x[i] = (part & 1) ? (x[i] * cs + px * sn) : (x[i] * cs - px * sn);
            }
        }
        if (!which) {
#pragma unroll
            for (int i = 0; i < 16; ++i) x[i] *= 0.125f * 1.4426950408889634f;
        }
        u32x4v o0, o1;
#pragma unroll
        for (int e = 0; e < 4; ++e) { o0[e] = cvt_pk_bf16(x[2 * e], x[2 * e + 1]); o1[e] = cvt_pk_bf16(x[8 + 2 * e], x[9 + 2 * e]); }
        *(u32x4v*)ptr = o0; *(u32x4v*)(ptr + 8) = o1;
    }
}

__device__ NOINL void phase_s5(const Params* gp, int L, L8* smem) {
    PHASE_ENTRY;
    const int wave = tidx() >> 6;
    if (wave < 2) {
        for (int item = bidx(); item < 256; item += gdim()) s5_stream(p, L >> 1, item >> 6, item & 63, wave, smem + wave * 51200);
    } else {
        qk_norm_rope(p, L >> 1, bidx() * 6 + wave - 2, gdim() * 6);
    }
}

__device__ __forceinline__ void attn_item(const Params& p, int L, int b, int h, int qb, int isctx, float lam, float lam_init, L8* smem) {
    const int j = L >> 1, tid = tidx(), w = tid >> 6, lane = tid & 63, r = lane & 31, hh = lane >> 5;
    const int m = w >> 2, qs = w & 3;
    const bf16_t* P1 = (const bf16_t*)(p.ws + OFF_P1);
    const bf16_t* vT = (const bf16_t*)(p.ws + OFF_VT);
    bf16_t* merged = (bf16_t*)(p.ws + OFF_MERGED);
    const int qrow0 = isctx ? (NLAT + b * 256 + qb * 128) : (b * 2048 + qb * 128);
    const int myrow = qrow0 + qs * 32 + r;
    bf16x8 Bq[4];
#pragma unroll
    for (int ks = 0; ks < 4; ++ks) Bq[ks] = *(const bf16x8*)(P1 + (size_t)myrow * N1 + 2048 + h * 128 + m * 64 + 16 * ks + 8 * hh);
    f32x16 ot[4];
#pragma unroll
    for (int dt = 0; dt < 4; ++dt)
#pragma unroll
        for (int i = 0; i < 16; ++i) ot[dt][i] = 0.f;
    float mrun = -1e30f, lrun = 0.f;
    const int nkt = isctx ? 4 : 36;
    const int krow = tid >> 3, kseg = tid & 7, vrow = tid >> 2, vseg = tid & 3;
    u32x4v kr0, kr1, vr0, vr1;
#define ATT_LOAD(kt) do { const int key_ = (kt) * 64 + krow; const int grow_ = key_ < 256 ? (NLAT + b * 256 + key_) : (b * 2048 + key_ - 256); \
        const bf16_t* ks_ = P1 + (size_t)grow_ * N1 + 3072 + h * 128 + kseg * 16; kr0 = *(const u32x4v*)ks_; kr1 = *(const u32x4v*)(ks_ + 8); \
        const bf16_t* vs_ = vT + ((size_t)(b * 8 + h) * 128 + vrow) * 2304 + (kt) * 64 + vseg * 16; vr0 = *(const u32x4v*)vs_; vr1 = *(const u32x4v*)(vs_ + 8); } while (0)
#define ATT_STORE(buf) do { L8* kb_ = smem + (buf) * 34816 + krow * 272 + kseg * 32; LV(u32x4v, kb_) = kr0; LV(u32x4v, kb_ + 16) = kr1; \
        L8* vb_ = smem + (buf) * 34816 + 17408 + vrow * 136 + vseg * 32; \
        LV(u32x2, vb_) = (u32x2){vr0[0], vr0[1]}; LV(u32x2, vb_ + 8) = (u32x2){vr0[2], vr0[3]}; LV(u32x2, vb_ + 16) = (u32x2){vr1[0], vr1[1]}; LV(u32x2, vb_ + 24) = (u32x2){vr1[2], vr1[3]}; } while (0)
    ATT_LOAD(0);
    ATT_STORE(0);
    __syncthreads();
    for (int kt = 0; kt < nkt; ++kt) {
        const int cur = kt & 1;
        if (kt + 1 < nkt) ATT_LOAD(kt + 1);
        const L8* Ks = smem + cur * 34816;
        const L8* Vs = Ks + 17408;
        f32x16 st[2];
#pragma unroll
        for (int k2 = 0; k2 < 2; ++k2) {
#pragma unroll
            for (int i = 0; i < 16; ++i) st[k2][i] = 0.f;
#pragma unroll
            for (int ks = 0; ks < 4; ++ks) { const bf16x8 A = LV(const bf16x8, Ks + (32 * k2 + r) * 272 + (m * 64 + 16 * ks + 8 * hh) * 2); st[k2] = mfma32(A, Bq[ks], st[k2]); }
        }
        float mx = st[0][0];
#pragma unroll
        for (int i = 0; i < 16; ++i) { mx = fmaxf(mx, st[0][i]); mx = fmaxf(mx, st[1][i]); }
        mx = fmaxf(mx, __shfl_xor(mx, 32));
        const float mnew = fmaxf(mrun, mx);
        const float alpha = __builtin_amdgcn_exp2f(mrun - mnew);
        mrun = mnew;
        float psum = 0.f;
#pragma unroll
        for (int k2 = 0; k2 < 2; ++k2)
#pragma unroll
            for (int i = 0; i < 16; ++i) { const float pv = __builtin_amdgcn_exp2f(st[k2][i] - mnew); st[k2][i] = pv; psum += pv; }
        lrun = lrun * alpha + psum;
#pragma unroll
        for (int dt = 0; dt < 4; ++dt)
#pragma unroll
            for (int i = 0; i < 16; ++i) ot[dt][i] *= alpha;
#pragma unroll
        for (int k2 = 0; k2 < 2; ++k2)
#pragma unroll
            for (int s = 0; s < 2; ++s) {
                const bf16x8 Bp = pack8(st[k2][8 * s], st[k2][8 * s + 1], st[k2][8 * s + 2], st[k2][8 * s + 3], st[k2][8 * s + 4], st[k2][8 * s + 5], st[k2][8 * s + 6], st[k2][8 * s + 7]);
#pragma unroll
                for (int dt = 0; dt < 4; ++dt) {
                    const L8* vp = Vs + (32 * dt + r) * 136 + (32 * k2 + 16 * s + 4 * hh) * 2;
                    const u32x2 lo = LV(const u32x2, vp), hi = LV(const u32x2, vp + 16);
                    const u32x4v av = {lo[0], lo[1], hi[0], hi[1]};
                    ot[dt] = mfma32(__builtin_bit_cast(bf16x8, av), Bp, ot[dt]);
                }
            }
        if (kt + 1 < nkt) ATT_STORE(cur ^ 1);
        __syncthreads();
    }
#undef ATT_LOAD
#undef ATT_STORE
    const float ltot = lrun + __shfl_xor(lrun, 32);
    const float inv = 1.f / ltot;
    LF* ex = (LF*)smem;
    if (m == 1) {
#pragma unroll
        for (int dt = 0; dt < 4; ++dt)
#pragma unroll
            for (int i = 0; i < 16; ++i) { const int dv = 32 * dt + (i & 3) + 8 * (i >> 2) + 4 * hh; ex[(qs * 128 + dv) * 32 + r] = ot[dt][i] * inv; }
    }
    __syncthreads();
    if (m == 0) {
        float ssq = 0.f;
#pragma unroll
        for (int dt = 0; dt < 4; ++dt)
#pragma unroll
            for (int i = 0; i < 16; ++i) { const int dv = 32 * dt + (i & 3) + 8 * (i >> 2) + 4 * hh;
                const float o = ot[dt][i] * inv - lam * ex[(qs * 128 + dv) * 32 + r]; ot[dt][i] = o; ssq += o * o; }
        ssq += __shfl_xor(ssq, 32);
        const float rstd = rsqrtf(ssq * (1.f / 128.f) + 1e-6f) * (1.f - lam_init);
        const float* sg = p.da_subln_g + j * 128;
#pragma unroll
        for (int dt = 0; dt < 4; ++dt)
#pragma unroll
            for (int g4 = 0; g4 < 4; ++g4) {
                const int dv = 32 * dt + 8 * g4 + 4 * hh;
                const f32x4 gg = *(const f32x4*)(sg + dv);
                const u32x2 z = *(const u32x2*)(P1 + (size_t)myrow * N1 + 5120 + h * 128 + dv);
                const float y0 = ot[dt][4 * g4] * rstd * gg[0] * silu_f(bf_lo(z[0])), y1 = ot[dt][4 * g4 + 1] * rstd * gg[1] * silu_f(bf_hi(z[0]));
                const float y2 = ot[dt][4 * g4 + 2] * rstd * gg[2] * silu_f(bf_lo(z[1])), y3 = ot[dt][4 * g4 + 3] * rstd * gg[3] * silu_f(bf_hi(z[1]));
                u32x2 o; o[0] = cvt_pk_bf16(y0, y1); o[1] = cvt_pk_bf16(y2, y3);
                *(u32x2*)(merged + (size_t)myrow * 2048 + 1024 + h * 128 + dv) = o;
            }
    }
    __syncthreads();
}

__device__ NOINL void phase_attn(const Params* gp, int L, L8* smem) {
    PHASE_ENTRY;
    const int j = L >> 1, tid = tidx(), lane = tid & 63;
    {
        const float* ybuf = (const float*)(p.ws + OFF_YBUF);
        const bf16_t* P1 = (const bf16_t*)(p.ws + OFF_P1);
        bf16_t* gbuf = (bf16_t*)(p.ws + OFF_GBUF);
        const float* dsk = p.s5_d + j * 1024;
        for (int idx = bidx() * 512 + tid; idx < NROW * 128; idx += gdim() * 512) {
            const int row = idx >> 7, c8 = (idx & 127) * 8;
            const float* y0 = ybuf + (size_t)row * 1024 + c8; const float* y1 = y0 + (size_t)NROW * 1024;
            const float4 a0 = *(const float4*)y0, a1 = *(const float4*)(y0 + 4), b0 = *(const float4*)y1, b1 = *(const float4*)(y1 + 4);
            const float4 d0 = *(const float4*)(dsk + c8), d1 = *(const float4*)(dsk + c8 + 4);
            const u32x4v u8 = *(const u32x4v*)(P1 + (size_t)row * N1 + c8);
            float y[8] = {a0.x + b0.x + d0.x * bf_lo(u8[0]), a0.y + b0.y + d0.y * bf_hi(u8[0]), a0.z + b0.z + d0.z * bf_lo(u8[1]), a0.w + b0.w + d0.w * bf_hi(u8[1]),
                          a1.x + b1.x + d1.x * bf_lo(u8[2]), a1.y + b1.y + d1.y * bf_hi(u8[2]), a1.z + b1.z + d1.z * bf_lo(u8[3]), a1.w + b1.w + d1.w * bf_hi(u8[3])};
#pragma unroll
            for (int e = 0; e < 8; ++e) { const float v = y[e], z = 0.7978845608028654f * (v + 0.044715f * v * v * v);
                const float th = 1.f - 2.f / (__expf(2.f * z) + 1.f); y[e] = 0.5f * v * (1.f + th); }
            u32x4v o; o[0] = cvt_pk_bf16(y[0], y[1]); o[1] = cvt_pk_bf16(y[2], y[3]); o[2] = cvt_pk_bf16(y[4], y[5]); o[3] = cvt_pk_bf16(y[6], y[7]);
            *(u32x4v*)(gbuf + (size_t)row * 1024 + c8) = o;
        }
    }
    const float* lv = p.da_lam + j * 256;
    const float s01 = wave_sum(lv[lane] * lv[64 + lane]), s23 = wave_sum(lv[128 + lane] * lv[192 + lane]);
    const float lam_init = 0.8f - 0.6f * expf(-0.3f * (float)L);
    const float lam = expf(s01) - expf(s23) + lam_init;
    for (int vb = bidx(); vb < 768; vb += gdim()) {
        const int rd = vb >> 8, bid = vb & 255, xcd = bid & 7, slot = bid >> 3;
        int bh, qb, isctx;
        if (rd < 2) { bh = xcd * 4 + (slot >> 3); qb = rd * 8 + (slot & 7); isctx = 0; }
        else { if (bid >= 64) continue; bh = xcd * 4 + (slot >> 1); qb = slot & 1; isctx = 1; }
        attn_item(p, L, bh >> 3, bh & 7, qb, isctx, lam, lam_init, smem);
    }
}

__device__ NOINL void phase_gla_pre(const Params* gp, int L, L8* smem) {
    PHASE_ENTRY;
    const int j = L >> 1, tid = tidx(), col = tid & 255, half = tid >> 8;
    const bf16_t* P1 = (const bf16_t*)(p.ws + OFF_P1);
    const float* rbuf = (const float*)(p.ws + OFF_RBUF);
    bf16_t* qd = (bf16_t*)(p.ws + OFF_QD); bf16_t* kd = (bf16_t*)(p.ws + OFF_KD); bf16_t* ket = (bf16_t*)(p.ws + OFF_KET);
    float* dec = (float*)(p.ws + OFF_DEC);
    LF* rl = (LF*)smem;
    LF* tot = rl + 1024;
    for (int it = bidx(); it < 1152; it += gdim()) {
        const int c = it >> 3, hd = (it >> 1) & 3, d = it & 1, row0 = c * 64;
        __syncthreads();
        for (int i = tid; i < 1024; i += 512) rl[i] = rbuf[(size_t)(row0 + (i >> 4)) * 32 + d * 16 + (i & 15)];
        float w2[16];
#pragma unroll
        for (int jj = 0; jj < 16; ++jj) w2[jj] = p.gla_wa2[((size_t)(j * 2 + d) * 16 + jj) * 1024 + hd * 256 + col];
        const float bias = p.gla_ba[(j * 2 + d) * 1024 + hd * 256 + col];
        __syncthreads();
        float la[32]; float run = 0.f;
#pragma unroll
        for (int tt = 0; tt < 32; ++tt) {
            const int t = half * 32 + tt; float lg = bias;
#pragma unroll
            for (int jj = 0; jj < 16; ++jj) lg += rl[t * 16 + jj] * w2[jj];
            la[tt] = (fminf(lg, 0.f) - __logf(1.f + __expf(-fabsf(lg)))) * (1.f / 16.f);
            run += la[tt];
        }
        tot[half * 256 + col] = run;
        __syncthreads();
        const float tot0 = tot[col], tot1 = tot[256 + col], bend = tot0 + tot1;
        float bcum[32];
        if (d == 0) { float a = half ? tot0 : 0.f;
#pragma unroll
            for (int tt = 0; tt < 32; ++tt) { a += la[tt]; bcum[tt] = a; } }
        else { float a = half ? 0.f : tot1;
#pragma unroll
            for (int tt = 31; tt >= 0; --tt) { a += la[tt]; bcum[tt] = a; } }
        const size_t gcol = hd * 256 + col;
        unsigned kev[16];
#pragma unroll
        for (int tp = 0; tp < 16; ++tp) {
            float ke2[2];
#pragma unroll
            for (int e = 0; e < 2; ++e) {
                const int tt = 2 * tp + e, row = row0 + half * 32 + tt;
                const float qv = bf2f(P1[(size_t)row * N1 + gcol]), kv = bf2f(P1[(size_t)row * N1 + 1024 + gcol]);
                qd[((size_t)d * NROW + row) * 1024 + gcol] = f2bf(qv * 0.0625f * __expf(bcum[tt]));
                kd[((size_t)d * NROW + row) * 1024 + gcol] = f2bf(kv * __expf(-bcum[tt]));
                ke2[e] = kv * __expf(bend - bcum[tt]);
            }
            kev[tp] = cvt_pk_bf16(ke2[0], ke2[1]);
        }
        bf16_t* kp = ket + (((size_t)d * 144 + c) * 1024 + gcol) * 64 + half * 32;
#pragma unroll
        for (int e = 0; e < 4; ++e) { u32x4v o = {kev[4 * e], kev[4 * e + 1], kev[4 * e + 2], kev[4 * e + 3]}; *(u32x4v*)(kp + 8 * e) = o; }
        if (half == 0) dec[((size_t)d * 144 + c) * 1024 + gcol] = __expf(bend);
    }
}

__device__ NOINL void phase_gla(const Params* gp, int L, L8* smem) {
    PHASE_ENTRY;
    const int tid = tidx(), w = tid >> 6, lane = tid & 63, n16 = lane & 15, q4 = lane >> 4;
    const bf16_t* qd = (const bf16_t*)(p.ws + OFF_QD); const bf16_t* kd = (const bf16_t*)(p.ws + OFF_KD); const bf16_t* ket = (const bf16_t*)(p.ws + OFF_KET);
    const bf16_t* vTg = (const bf16_t*)(p.ws + OFF_VT);
    const float* decg = (const float*)(p.ws + OFF_DEC);
    float* obuf = (float*)(p.ws + OFF_OBUF);
    L8* Qd = smem; L8* Kd = smem + 33792; L8* KeT = smem + 67584; L8* VTs = smem + 104448;
    L8* STs = smem + 113664; L8* Ps = smem + 147456; LF* decl = (LF*)(smem + 156672);
    for (int vb = bidx(); vb < 256; vb += gdim()) {
        const int xcd = vb & 7, slot = vb >> 3, stream = xcd * 4 + (slot >> 3), dvs = slot & 7;
        const int b = stream >> 3, hd = (stream >> 1) & 3, d = stream & 1;
        __syncthreads();
        for (int i = tid; i < 33792 / 16; i += 512) LV(u32x4v, STs + 16 * i) = (u32x4v){0u, 0u, 0u, 0u};
        f32x4 S[2][4];
#pragma unroll
        for (int mt = 0; mt < 2; ++mt)
#pragma unroll
            for (int nt = 0; nt < 4; ++nt) S[mt][nt] = (f32x4){0.f, 0.f, 0.f, 0.f};
        for (int cq = 0; cq < 36; ++cq) {
            const int isctx = cq < 4, idx = isctx ? cq : cq - 4, nseg = isctx ? 4 : 32, cs_ = d ? (nseg - 1 - idx) : idx;
            const int c = isctx ? (128 + b * 4 + cs_) : (b * 32 + cs_), row0 = c * 64;
            const bool need_o = !(isctx && L == 3);
            __syncthreads();
            {
                const int r8 = tid >> 3, s8 = tid & 7;
                if (need_o) { const bf16_t* src = qd + ((size_t)d * NROW + row0 + r8) * 1024 + hd * 256 + s8 * 32; L8* dst = Qd + r8 * 528 + s8 * 64;
#pragma unroll
                    for (int e = 0; e < 4; ++e) LV(u32x4v, dst + 16 * e) = *(const u32x4v*)(src + 8 * e); }
                { const bf16_t* src = kd + ((size_t)d * NROW + row0 + r8) * 1024 + hd * 256 + s8 * 32; L8* dst = Kd + r8 * 528 + s8 * 64;
#pragma unroll
                    for (int e = 0; e < 4; ++e) LV(u32x4v, dst + 16 * e) = *(const u32x4v*)(src + 8 * e); }
                { const int dk = tid >> 1, sg = tid & 1; const bf16_t* src = ket + (((size_t)d * 144 + c) * 1024 + hd * 256 + dk) * 64 + sg * 32; L8* dst = KeT + dk * 144 + sg * 64;
#pragma unroll
                    for (int e = 0; e < 4; ++e) LV(u32x4v, dst + 16 * e) = *(const u32x4v*)(src + 8 * e); }
                { const bf16_t* src = vTg + ((size_t)c * 2048 + hd * 512 + dvs * 64 + r8) * 64 + s8 * 8; LV(u32x4v, VTs + r8 * 144 + s8 * 16) = *(const u32x4v*)src; }
                if (tid < 256) decl[tid] = decg[((size_t)d * 144 + c) * 1024 + hd * 256 + tid];
            }
            __syncthreads();
            if (need_o) {
                const int mt = w >> 1, nb = 2 * (w & 1);
                {
                    f32x4 sc[2] = {(f32x4){0.f, 0.f, 0.f, 0.f}, (f32x4){0.f, 0.f, 0.f, 0.f}};
#pragma unroll
                    for (int ks = 0; ks < 8; ++ks) {
                        const bf16x8 A = LV(const bf16x8, Kd + (16 * mt + n16) * 528 + (32 * ks + 8 * q4) * 2);
#pragma unroll
                        for (int nn = 0; nn < 2; ++nn) { const bf16x8 B = LV(const bf16x8, Qd + (16 * (nb + nn) + n16) * 528 + (32 * ks + 8 * q4) * 2); sc[nn] = mfma16(A, B, sc[nn]); }
                    }
#pragma unroll
                    for (int nn = 0; nn < 2; ++nn) {
                        const int t = 16 * (nb + nn) + n16, s0 = 16 * mt + 4 * q4;
                        float v[4];
#pragma unroll
                        for (int i = 0; i < 4; ++i) { const int s = s0 + i; const bool keep = d ? (t <= s) : (t >= s); v[i] = keep ? sc[nn][i] : 0.f; }
                        u32x2 o; o[0] = cvt_pk_bf16(v[0], v[1]); o[1] = cvt_pk_bf16(v[2], v[3]);
                        LV(u32x2, Ps + t * 144 + s0 * 2) = o;
                    }
                }
                __syncthreads();
                {
                    f32x4 oa[2] = {(f32x4){0.f, 0.f, 0.f, 0.f}, (f32x4){0.f, 0.f, 0.f, 0.f}};
#pragma unroll
                    for (int ks = 0; ks < 2; ++ks) {
                        const bf16x8 A = LV(const bf16x8, Ps + (16 * mt + n16) * 144 + (32 * ks + 8 * q4) * 2);
#pragma unroll
                        for (int nn = 0; nn < 2; ++nn) { const bf16x8 B = LV(const bf16x8, VTs + (16 * (nb + nn) + n16) * 144 + (32 * ks + 8 * q4) * 2); oa[nn] = mfma16(A, B, oa[nn]); }
                    }
#pragma unroll
                    for (int ks = 0; ks < 8; ++ks) {
                        const bf16x8 A = LV(const bf16x8, Qd + (16 * mt + n16) * 528 + (32 * ks + 8 * q4) * 2);
#pragma unroll
                        for (int nn = 0; nn < 2; ++nn) { const bf16x8 B = LV(const bf16x8, STs + (16 * (nb + nn) + n16) * 528 + (32 * ks + 8 * q4) * 2); oa[nn] = mfma16(A, B, oa[nn]); }
                    }
#pragma unroll
                    for (int nn = 0; nn < 2; ++nn)
#pragma unroll
                        for (int i = 0; i < 4; ++i)
                            obuf[((size_t)d * NROW + row0 + 16 * mt + 4 * q4 + i) * 2048 + hd * 512 + dvs * 64 + 16 * (nb + nn) + n16] = oa[nn][i];
                }
            }
#pragma unroll
            for (int mt = 0; mt < 2; ++mt) { const f32x4 dv4 = LV(const f32x4, decl + 32 * w + 16 * mt + 4 * q4);
#pragma unroll
                for (int nt = 0; nt < 4; ++nt) S[mt][nt] *= dv4; }
#pragma unroll
            for (int ks = 0; ks < 2; ++ks) {
                bf16x8 A[2];
#pragma unroll
                for (int mt = 0; mt < 2; ++mt) A[mt] = LV(const bf16x8, KeT + (32 * w + 16 * mt + n16) * 144 + (32 * ks + 8 * q4) * 2);
#pragma unroll
                for (int nt = 0; nt < 4; ++nt) { const bf16x8 B = LV(const bf16x8, VTs + (16 * nt + n16) * 144 + (32 * ks + 8 * q4) * 2);
#pragma unroll
                    for (int mt = 0; mt < 2; ++mt) S[mt][nt] = mfma16(A[mt], B, S[mt][nt]); }
            }
            __syncthreads();
#pragma unroll
            for (int mt = 0; mt < 2; ++mt)
#pragma unroll
                for (int nt = 0; nt < 4; ++nt) { u32x2 o; o[0] = cvt_pk_bf16(S[mt][nt][0], S[mt][nt][1]); o[1] = cvt_pk_bf16(S[mt][nt][2], S[mt][nt][3]);
                    LV(u32x2, STs + (16 * nt + n16) * 528 + (32 * w + 16 * mt + 4 * q4) * 2) = o; }
        }
    }
}

__device__ NOINL void phase_gla_finish(const Params* gp, int L, L8* smem) {
    PHASE_ENTRY;
    const int j = L >> 1, wave = tidx() >> 6, lane = tidx() & 63;
    const float* obuf = (const float*)(p.ws + OFF_OBUF);
    const bf16_t* P1 = (const bf16_t*)(p.ws + OFF_P1);
    bf16_t* merged = (bf16_t*)(p.ws + OFF_MERGED);
    const float* gn = p.gla_norm_g + j * 512;
    const int nrows = (L == 3) ? NLAT : NROW;
    for (int it = bidx() * 8 + wave; it < nrows * 4; it += gdim() * 8) {
        const int row = it >> 2, hd = it & 3, c0 = hd * 512 + lane * 8;
        const float* o0 = obuf + (size_t)row * 2048 + c0; const float* o1 = o0 + (size_t)NROW * 2048;
        const float4 a0 = *(const float4*)o0, a1 = *(const float4*)(o0 + 4), b0 = *(const float4*)o1, b1 = *(const float4*)(o1 + 4);
        float v[8] = {a0.x + b0.x, a0.y + b0.y, a0.z + b0.z, a0.w + b0.w, a1.x + b1.x, a1.y + b1.y, a1.z + b1.z, a1.w + b1.w};
        float ss = 0.f;
#pragma unroll
        for (int e = 0; e < 8; ++e) ss += v[e] * v[e];
        ss = wave_sum(ss);
        const float rstd = rsqrtf(ss * (1.f / 512.f) + 1e-6f);
        const float4 g0 = *(const float4*)(gn + lane * 8), g1 = *(const float4*)(gn + lane * 8 + 4);
        const u32x4v z8 = *(const u32x4v*)(P1 + (size_t)row * N1 + 4096 + c0);
        const float gg[8] = {g0.x, g0.y, g0.z, g0.w, g1.x, g1.y, g1.z, g1.w};
        float y[8];
#pragma unroll
        for (int e = 0; e < 8; ++e) { const float z = (e & 1) ? bf_hi(z8[e >> 1]) : bf_lo(z8[e >> 1]); y[e] = v[e] * rstd * gg[e] * silu_f(z); }
        u32x4v o; o[0] = cvt_pk_bf16(y[0], y[1]); o[1] = cvt_pk_bf16(y[2], y[3]); o[2] = cvt_pk_bf16(y[4], y[5]); o[3] = cvt_pk_bf16(y[6], y[7]);
        *(u32x4v*)(merged + (size_t)row * 2048 + c0) = o;
    }
}

constexpr int N_PHASES = 25;
__device__ NOINL void phase_gemm1(const Params* gp, int L, L8* smem) {
    PHASE_ENTRY;
    const int odd = L & 1;
    EpiIn E{(bf16_t*)(p.ws + OFF_P1), (bf16_t*)(p.ws + OFF_VT), (float*)(p.ws + OFF_RBUF), odd};
    run_gemm(smem, (const bf16_t*)(p.ws + OFF_H), (const bf16_t*)(p.ws + OFF_WTIN + (size_t)L * SZ_WTIN1), NROW, odd ? N1P : N1, 2048, E);
}
__device__ NOINL void phase_glu(const Params* gp, int L, L8* smem) {
    PHASE_ENTRY;
    EpiGlu E{(const bf16_t*)(p.ws + OFF_GBUF), (const bf16_t*)(p.ws + OFF_P1), (bf16_t*)(p.ws + OFF_MERGED)};
    run_gemm(smem, (const bf16_t*)(p.ws + OFF_GBUF), (const bf16_t*)(p.ws + OFF_WTGLU + (size_t)(L >> 1) * SZ_WTGLU1), NROW, 1024, 1024, E);
}
__device__ NOINL void phase_gemm2(const Params* gp, int L, L8* smem) {
    PHASE_ENTRY;
    float* xbuf = (float*)(p.ws + OFF_XBUF);
    EpiOut E{L == 0 ? p.x : xbuf, L == 0 ? p.ctx : xbuf + (size_t)NLAT * 2048, L == 3 ? p.out : xbuf, xbuf + (size_t)NLAT * 2048, (const float*)(p.ws + OFF_MOD) + (size_t)L * 5 * 6144};
    run_gemm(smem, (const bf16_t*)(p.ws + OFF_MERGED), (const bf16_t*)(p.ws + OFF_WTOUT + (size_t)L * SZ_WTOUT1), L == 3 ? NLAT : NROW, 2048, 2048, E);
}
__device__ __forceinline__ void run_phase(const Params* gp, int ph, L8* smem) {
    if (ph == 0) { phase_prologue(gp, 0, smem); return; }
    const int L = (ph - 1) / 6, s = (ph - 1) % 6, odd = L & 1;
    if (s == 0) phase_norm(gp, L, smem);
    else if (s == 1) phase_gemm1(gp, L, smem);
    else if (s == 2) { if (odd) phase_gla_pre(gp, L, smem); else phase_s5(gp, L, smem); }
    else if (s == 3) { if (odd) phase_gla(gp, L, smem); else phase_attn(gp, L, smem); }
    else if (s == 4) { if (odd) phase_gla_finish(gp, L, smem); else phase_glu(gp, L, smem); }
    else phase_gemm2(gp, L, smem);
}

__global__ void __launch_bounds__(512) hybrid_fwd_megakernel(Params p) {
    extern __shared__ __attribute__((aligned(16))) unsigned char smem_raw[];
    L8* smem = (L8*)smem_raw;
    cg::grid_group grid = cg::this_grid();
    const Params* gp = &p;
    for (int ph = p.ph_lo; ph < p.ph_hi; ++ph) {
        if (ph > p.ph_lo) grid.sync();
        run_phase(gp, ph, smem);
    }
}

extern "C" void kernel_launch(void* const* d_in, const int* in_sizes, int n_in, void* d_out, int out_size, void* d_ws, size_t ws_size, hipStream_t stream) {
    static int grid_blocks = 0;
    if (grid_blocks == 0) {
        if (n_in != 28 || ws_size < WS_END) { fprintf(stderr, "kernel_launch: expected 28 inputs and >= %zu bytes of workspace; got %d, %zu\n", (size_t)WS_END, n_in, ws_size); grid_blocks = -1; return; }
        int dev = 0, cus = 0, per_cu = 0;
        hipGetDevice(&dev);
        hipDeviceGetAttribute(&cus, hipDeviceAttributeMultiprocessorCount, dev);
        if (hipFuncSetAttribute((const void*)hybrid_fwd_megakernel, hipFuncAttributeMaxDynamicSharedMemorySize, LDS_BYTES) != hipSuccess) { fprintf(stderr, "kernel_launch: hipFuncSetAttribute failed\n"); grid_blocks = -1; return; }
        if (hipOccupancyMaxActiveBlocksPerMultiprocessor(&per_cu, (const void*)hybrid_fwd_megakernel, 512, LDS_BYTES) != hipSuccess || per_cu < 1) { fprintf(stderr, "kernel_launch: occupancy query gave %d\n", per_cu); per_cu = 1; }
        (void)hipGetLastError();
        grid_blocks = cus * per_cu;
    }
    if (grid_blocks < 0) return;
    Params p{};
    const float** ip = (const float**)&p;
    for (int i = 0; i < 28; ++i) ip[i] = (const float*)d_in[i];
    p.out = (float*)d_out; p.ws = (unsigned char*)d_ws; p.ph_lo = 0; p.ph_hi = N_PHASES;
    void* args[] = {&p};
    hipError_t e = hipLaunchCooperativeKernel((const void*)hybrid_fwd_megakernel, dim3(grid_blocks), dim3(512), args, LDS_BYTES, stream);
    if (e != hipSuccess) fprintf(stderr, "cooperative launch failed: %s (grid %d)\n", hipGetErrorString(e), grid_blocks);
}
```

```cpp
#include <hip/hip_runtime.h>
#include <hip/hip_cooperative_groups.h>
#include <cstdio>
namespace cg = cooperative_groups;

__device__ __forceinline__ int tidx() { int t = threadIdx.x; asm volatile("" : "+v"(t)); return t; }
__device__ __forceinline__ int bidx() { int t = blockIdx.x; asm volatile("" : "+s"(t)); return t; }
__device__ __forceinline__ int gdim() { int t = gridDim.x; asm volatile("" : "+s"(t)); return t; }
#define XB_TMO      128
#define XB_XCNT(j)  (256  + 64 * (j))
#define XB_XSUB(j)  (1280 + 64 * (j))
#define XB_XGEN(j)  (2304 + 64 * (j))
#define XB_TOP      3328
#define XB_TOPGEN   3392
#define XCD_BAR_WORDS 3456
#define XB_SPIN_CAP (1u << 18)
#define LAS __attribute__((address_space(3)))

__device__ __forceinline__ unsigned xb_ld(unsigned* p)              { return __hip_atomic_load(p, __ATOMIC_RELAXED, __HIP_MEMORY_SCOPE_AGENT); }
__device__ __forceinline__ unsigned xb_add(unsigned* p, unsigned v) { return __hip_atomic_fetch_add(p, v, __ATOMIC_RELAXED, __HIP_MEMORY_SCOPE_AGENT); }
__device__ __forceinline__ unsigned xb_xcc_id() { return (unsigned)__builtin_amdgcn_s_getreg((3 << 11) | 20) & 0xFu; }
#define XB_SPIN(cond, bar) do { unsigned _sp = 0; while (cond) { __builtin_amdgcn_s_sleep(1); \
    if ((++_sp & 255u) == 0u) { if (xb_ld(&(bar)[XB_TMO])) break; if (_sp > XB_SPIN_CAP) { atomicAdd(&(bar)[XB_TMO], 1u); break; } } } } while (0)

struct XcdBarrier {
    unsigned* bar; unsigned x;
    volatile LAS unsigned* st;
};

__device__ __forceinline__ XcdBarrier xcd_barrier_post(unsigned* bar, volatile LAS unsigned* st) {
    XcdBarrier b; b.bar = bar; b.x = xb_xcc_id(); b.st = st;
    if (tidx() == 0) (void)xb_add(&bar[XB_XCNT(b.x)], 1u);
    return b;
}
__device__ __forceinline__ void xcd_barrier_complete(unsigned* bar, unsigned x, unsigned& nloc, unsigned& nx) {
    const unsigned G = gridDim.x;
    unsigned sum, cnt, mine, sp = 0u;
    for (;;) {
        sum = 0u; cnt = 0u; mine = 0u;
#pragma unroll
        for (unsigned j = 0; j < 16; ++j) { const unsigned c = xb_ld(&bar[XB_XCNT(j)]); sum += c; cnt += (c > 0u) ? 1u : 0u; mine = (j == x) ? c : mine; }
        if (sum == G) break;
        __builtin_amdgcn_s_sleep(1);
        if ((++sp & 255u) == 0u) { if (xb_ld(&bar[XB_TMO])) break; if (sp > XB_SPIN_CAP) { atomicAdd(&bar[XB_TMO], 1u); break; } }
    }
    nloc = mine > 0u ? mine : 1u; nx = cnt > 0u ? cnt : 1u;
}

__device__ __forceinline__ void xcd_barrier(const XcdBarrier& b) {
    asm volatile("s_waitcnt vmcnt(0)" ::: "memory");
    __syncthreads();
    if (tidx() == 0) {
        unsigned* bar = b.bar;
        __builtin_amdgcn_s_waitcnt(0);
        unsigned nloc = b.st[0], nx = b.st[1];
        if (nloc == 0u) { xcd_barrier_complete(bar, b.x, nloc, nx); b.st[0] = nloc; b.st[1] = nx; }
        const unsigned old = xb_add(&bar[XB_XSUB(b.x)], 1u);
        const unsigned gen = old / nloc;
        if (old + 1u == (gen + 1u) * nloc) {
            __builtin_amdgcn_fence(__ATOMIC_RELEASE, "agent");
            asm volatile("s_waitcnt vmcnt(0)" ::: "memory");
            const unsigned og = xb_add(&bar[XB_TOP], 1u);
            const unsigned tg = og / nx;
            if (og + 1u == (tg + 1u) * nx) xb_add(&bar[XB_TOPGEN], 1u);
            else XB_SPIN(xb_ld(&bar[XB_TOPGEN]) == tg, bar);
            __builtin_amdgcn_fence(__ATOMIC_ACQUIRE, "agent");
            xb_add(&bar[XB_XGEN(b.x)], 1u);
            asm volatile("s_waitcnt vmcnt(0)" ::: "memory");
        } else {
            XB_SPIN(xb_ld(&bar[XB_XGEN(b.x)]) == gen, bar);
            __builtin_amdgcn_fence(__ATOMIC_ACQUIRE, "agent");
            asm volatile("s_waitcnt vmcnt(0)" ::: "memory");
        }
    }
    __syncthreads();
}

namespace pg8 {
#define PG8_LAS __attribute__((address_space(3)))
typedef unsigned short bf16_t;
typedef short bf16x8 __attribute__((ext_vector_type(8)));
typedef float f32x4 __attribute__((ext_vector_type(4)));
typedef unsigned u32x4 __attribute__((ext_vector_type(4)));
constexpr int BM = 256, BK = 64, HALF = 128, HTB = HALF * BK * 2  , STAGE_BYTES = 8 * HTB, NXCD = 8, WGM = 8;

__host__ __device__ __forceinline__ int lds_byte(int r, int c) { const int st = (r >> 4) * 2 + (c >> 5), rr = r & 15, cc = c & 31, ob = rr * 64 + cc * 2; return st * 1024 + (ob ^ (((ob >> 9) & 1) << 5)); }
__host__ __device__ __forceinline__ void stage_rc(int b, int& R, int& C) { const int st = b / 1024, sb = b % 1024, swz = sb ^ (((sb >> 9) & 1) << 5); R = (st >> 1) * 16 + swz / 64; C = (st & 1) * 32 + (swz % 64) / 2; }
__host__ __device__ __forceinline__ int perm32(int rho) { const int n = rho >> 4, i = rho & 15; return 8 * (i >> 2) + 4 * n + (i & 3); }

struct Unit { int pm, pn; };
struct Gemm { const bf16_t* A; const bf16_t* Bt; int M, N, K; };

struct StaticOrder {
    int nM, nN, nwg, G, c;
    __host__ __device__ void init(int M, int N, int G_, int c_) { nM = M / BM; nN = N / BM; nwg = nM * nN; G = G_; c = c_; }
    __host__ __device__ bool next(int i, Unit& u) const {
        const long L = (long)i * G + c; if (L >= nwg) return false;
        int wgid = (int)L; { const int q = nwg / NXCD, r = nwg % NXCD, xcd = wgid % NXCD, off = wgid / NXCD; wgid = (xcd < r ? xcd * (q + 1) : r * (q + 1) + (xcd - r) * q) + off; }
        const int nig = WGM * nN, gid = wgid / nig, fm = gid * WGM, gsz = (nM - fm) < WGM ? (nM - fm) : WGM;
        u.pm = fm + ((wgid % nig) % gsz); u.pn = (wgid % nig) / gsz; return true;
    }
    __device__ __forceinline__ void a_ready(const Unit&) const {}
    __device__ __forceinline__ void done(const Unit&) const {}
};
__device__ __forceinline__ unsigned cvt_pk_bf16(float lo, float hi) { unsigned r; asm volatile("v_cvt_pk_bf16_f32 %0, %1, %2" : "=v"(r) : "v"(lo), "v"(hi)); return r; }
template <class Epi, class Sched, bool STAMP = false>
__device__ __forceinline__ void gemm_phase(PG8_LAS unsigned char* lds, const Gemm g, const Sched& S, const Epi& E, unsigned long long* stamps) {
    const int tid = tidx(), wid = __builtin_amdgcn_readfirstlane(tid >> 6), lane = tid & 63, wr = wid >> 2, wc = wid & 3, fr = lane & 15, fq = lane >> 4;
    const int K = g.K, nt = K / BK;
    int ts_lo = 0, ts_hi = 0, nts = 0; const unsigned long long rt_entry = STAMP ? (unsigned long long)wall_clock64() : 0ull;
#define PG8_STAMP() do { if (STAMP && wid == 0 && nts < 64) { const unsigned long long _c = (unsigned long long)clock64(); \
        ts_lo = (lane == nts) ? (int)(unsigned)_c : ts_lo; ts_hi = (lane == nts) ? (int)(unsigned)(_c >> 32) : ts_hi; ++nts; } } while (0)
    PG8_STAMP();
    unsigned voffA[2], voffB[2];
#pragma unroll
    for (int i = 0; i < 2; ++i) { int R, C; stage_rc(tid * 16 + i * 8192, R, C); const int Rb = Epi::PERM ? ((R & ~31) + perm32(R & 31)) : R;
        voffA[i] = (unsigned)(R * K + C) * 2u; voffB[i] = (unsigned)(Rb * K + C) * 2u; }
    const size_t kstep = (size_t)(BK * 2);
    const size_t hstep = (size_t)HALF * K * 2;
    const size_t tstep = 2 * hstep;
    const unsigned ldsw = (unsigned)wid * 1024u;
    const int aoff = lds_byte(wr * 64 + fr, fq * 8), boff = lds_byte(wc * 32 + fr, fq * 8);
#define PG8_SA(b, h) (((b) * 2 + (h)) * HTB)
#define PG8_SB(b, h) ((4 + (b) * 2 + (h)) * HTB)
#define PG8_STAGE(bufoff, gbase, voff) do { _Pragma("unroll") for (int _i = 0; _i < 2; ++_i) \
        __builtin_amdgcn_global_load_lds((const unsigned*)((const char*)(gbase) + (voff)[_i]), (PG8_LAS unsigned*)(lds + (bufoff) + ldsw + _i * 8192), 16, 0, 0); } while (0)
#define PG8_LDA(dst, b, h) do { _Pragma("unroll") for (int m = 0; m < 4; ++m) _Pragma("unroll") for (int k = 0; k < 2; ++k) dst[m][k] = *(const PG8_LAS bf16x8*)(lds + PG8_SA(b, h) + aoff + m * 2048 + k * 1024); } while (0)
#define PG8_LDB(dst, b, h) do { _Pragma("unroll") for (int n = 0; n < 2; ++n) _Pragma("unroll") for (int k = 0; k < 2; ++k) dst[n][k] = *(const PG8_LAS bf16x8*)(lds + PG8_SB(b, h) + boff + n * 2048 + k * 1024); } while (0)
#define PG8_MMA(ai, bj, At, Bt) do { __builtin_amdgcn_s_setprio(1); _Pragma("unroll") for (int m = 0; m < 4; ++m) _Pragma("unroll") for (int n = 0; n < 2; ++n) _Pragma("unroll") for (int k = 0; k < 2; ++k) \
        acc[ai][bj][m][n] = __builtin_amdgcn_mfma_f32_16x16x32_bf16(Bt[n][k], At[m][k], acc[ai][bj][m][n], 0, 0, 0); __builtin_amdgcn_s_setprio(0); } while (0)
#define PG8_WAIT_V(n) asm volatile("s_waitcnt vmcnt(" #n ")" ::: "memory")
#define PG8_WAIT_L(n) asm volatile("s_waitcnt lgkmcnt(" #n ")" ::: "memory")
#define PG8_BAR __builtin_amdgcn_s_barrier()
#define PG8_SCHED __builtin_amdgcn_sched_barrier(0)
    Unit cur, nxt; int ui = 0;
    if (!S.next(0, cur)) return;
    f32x4 acc[2][2][4][2];
#pragma unroll
    for (int a = 0; a < 2; ++a)
#pragma unroll
        for (int b = 0; b < 2; ++b)
#pragma unroll
            for (int m = 0; m < 4; ++m)
#pragma unroll
                for (int n = 0; n < 2; ++n) acc[a][b][m][n] = (f32x4){0.f, 0.f, 0.f, 0.f};
    bf16x8 At[4][2], B0[2][2], B1[2][2];
    const char* cA = (const char*)g.A + (size_t)cur.pm * tstep; const char* cB = (const char*)g.Bt + (size_t)cur.pn * tstep;
    S.a_ready(cur);
    PG8_STAGE(PG8_SB(0, 0), cB, voffB); PG8_STAGE(PG8_SA(0, 0), cA, voffA); PG8_STAGE(PG8_SB(0, 1), cB + hstep, voffB); PG8_STAGE(PG8_SA(0, 1), cA + hstep, voffA);
    if (wr == 1) PG8_BAR;
    PG8_WAIT_V(4); PG8_BAR;
    PG8_STAGE(PG8_SB(1, 0), cB + kstep, voffB); PG8_STAGE(PG8_SA(1, 0), cA + kstep, voffA); PG8_STAGE(PG8_SB(1, 1), cB + hstep + kstep, voffB);
    PG8_WAIT_V(6); PG8_BAR;
    PG8_STAMP();
    for (;;) {
        const bool has_next = S.next(ui + 1, nxt);
        const char* nA = has_next ? (const char*)g.A + (size_t)nxt.pm * tstep : cA; const char* nB = has_next ? (const char*)g.Bt + (size_t)nxt.pn * tstep : cB;
        for (int t = 0; t < nt; t += 2) {
            const bool last = (t == nt - 2);
            const char* a1 = cA + (size_t)(t + 1) * kstep;
            const char* a2 = last ? nA : cA + (size_t)(t + 2) * kstep; const char* b2 = last ? nB : cB + (size_t)(t + 2) * kstep;
            const char* a3 = a2 + kstep; const char* b3 = b2 + kstep;
            if (last && has_next) S.a_ready(nxt);
            PG8_LDB(B0, 0, 0); PG8_SCHED; PG8_LDA(At, 0, 0); PG8_STAGE(PG8_SA(1, 1), a1 + hstep, voffA);
            PG8_WAIT_L(8); PG8_BAR; PG8_WAIT_L(0); PG8_MMA(0, 0, At, B0); PG8_BAR; PG8_SCHED;
            PG8_LDB(B1, 0, 1); PG8_STAGE(PG8_SB(0, 0), b2, voffB);
            PG8_BAR; PG8_WAIT_L(0); PG8_MMA(0, 1, At, B1); PG8_BAR;
            PG8_LDA(At, 0, 1); PG8_STAGE(PG8_SA(0, 0), a2, voffA);
            PG8_BAR; PG8_WAIT_L(0); PG8_MMA(1, 0, At, B0); PG8_BAR; PG8_SCHED;
            PG8_STAGE(PG8_SB(0, 1), b2 + hstep, voffB);
            PG8_WAIT_V(6); PG8_BAR; PG8_MMA(1, 1, At, B1); PG8_BAR;
            PG8_LDB(B0, 1, 0); PG8_SCHED; PG8_LDA(At, 1, 0); PG8_STAGE(PG8_SA(0, 1), a2 + hstep, voffA);
            PG8_WAIT_L(8); PG8_BAR; PG8_WAIT_L(0); PG8_MMA(0, 0, At, B0); PG8_BAR; PG8_SCHED;
            PG8_LDB(B1, 1, 1); PG8_STAGE(PG8_SB(1, 0), b3, voffB);
            PG8_BAR; PG8_WAIT_L(0); PG8_MMA(0, 1, At, B1); PG8_BAR;
            PG8_LDA(At, 1, 1); PG8_STAGE(PG8_SA(1, 0), a3, voffA);
            PG8_BAR; PG8_WAIT_L(0); PG8_MMA(1, 0, At, B0); PG8_BAR; PG8_SCHED;
            PG8_STAGE(PG8_SB(1, 1), b3 + hstep, voffB);
            PG8_WAIT_V(6); PG8_BAR; PG8_MMA(1, 1, At, B1); PG8_BAR;
        }
        PG8_STAMP();
        if constexpr (!Epi::AFTER_DRAIN) { E(acc, cur, wr, wc, fr, fq); S.done(cur); }
        PG8_STAMP();
        if (!has_next) break;
#pragma unroll
        for (int a = 0; a < 2; ++a)
#pragma unroll
            for (int b = 0; b < 2; ++b)
#pragma unroll
                for (int m = 0; m < 4; ++m)
#pragma unroll
                    for (int n = 0; n < 2; ++n) acc[a][b][m][n] = (f32x4){0.f, 0.f, 0.f, 0.f};
        cur = nxt; cA = nA; cB = nB; ++ui;
    }
    PG8_WAIT_V(0);
    if (wr == 0) PG8_BAR;
    PG8_BAR;
    if constexpr (Epi::AFTER_DRAIN) { E.fused(acc, cur, wr, wc, fr, fq, lds, wid, lane); S.done(cur); }
    PG8_STAMP();
    if (STAMP && wid == 0) { stamps[lane] = lane < nts ? (((unsigned long long)(unsigned)ts_hi << 32) | (unsigned)ts_lo) : 0ull;
        if (lane == 62) stamps[62] = rt_entry; if (lane == 63) stamps[63] = (unsigned long long)wall_clock64(); }
#undef PG8_STAMP
#undef PG8_SA
#undef PG8_SB
#undef PG8_STAGE
#undef PG8_LDA
#undef PG8_LDB
#undef PG8_MMA
#undef PG8_WAIT_V
#undef PG8_WAIT_L
#undef PG8_BAR
#undef PG8_SCHED
}
}

using pg8::bf16_t; using pg8::bf16x8; using pg8::f32x4; using pg8::cvt_pk_bf16;
typedef float f32x16 __attribute__((ext_vector_type(16)));
typedef short bf16x4 __attribute__((ext_vector_type(4)));
typedef unsigned u32x2 __attribute__((ext_vector_type(2)));
typedef float f32x2v __attribute__((ext_vector_type(2)));
typedef unsigned u32x4v __attribute__((ext_vector_type(4)));

constexpr int DM = 2048, NLAT = 8192, NROW = 9216, N1 = 6144, N1P = 6400;
constexpr size_t SZ_WTIN1 = (size_t)N1P * DM * 2, SZ_WTOUT1 = (size_t)DM * DM * 2, SZ_WTGLU1 = (size_t)1024 * 1024 * 2;
constexpr size_t OFF_WTIN = 0;
constexpr size_t OFF_WTOUT = OFF_WTIN + 4 * SZ_WTIN1;
constexpr size_t OFF_WTGLU = OFF_WTOUT + 4 * SZ_WTOUT1;
constexpr size_t OFF_MOD = OFF_WTGLU + 2 * SZ_WTGLU1;
constexpr size_t OFF_ROPE = OFF_MOD + (size_t)4 * 5 * 6144 * 4;
constexpr size_t OFF_H = OFF_ROPE + 8192;
constexpr size_t OFF_P1 = OFF_H + (size_t)NROW * DM * 2;
constexpr size_t OFF_XBUF = OFF_P1 + (size_t)NROW * N1 * 2;
constexpr size_t OFF_MERGED = OFF_XBUF + (size_t)NROW * DM * 4;
constexpr size_t OFF_VT = OFF_MERGED + (size_t)NROW * DM * 2;
constexpr size_t OFF_RBUF = OFF_VT + (size_t)NROW * DM * 2;
constexpr size_t OFF_DEC = OFF_RBUF + (size_t)NROW * 32 * 4;
constexpr size_t OFF_U = OFF_DEC + (size_t)2 * 144 * 1024 * 4;
constexpr size_t OFF_YBUF = OFF_U;
constexpr size_t OFF_GBUF = OFF_YBUF + (size_t)2 * NROW * 1024 * 4;
constexpr size_t OFF_QD = OFF_U;
constexpr size_t OFF_KD = OFF_QD + (size_t)2 * NROW * 1024 * 2;
constexpr size_t OFF_KET = OFF_KD + (size_t)2 * NROW * 1024 * 2;
constexpr size_t OFF_OBUF = OFF_KET + (size_t)2 * NROW * 1024 * 2;
constexpr size_t OFF_PARAMS = OFF_OBUF + (size_t)2 * NROW * DM * 4;
constexpr size_t OFF_BAR = OFF_PARAMS + 1024 * 256;
constexpr size_t OFF_CNT = OFF_BAR + 16384;
constexpr size_t OFF_DBG = OFF_CNT + 8 * 8 * 64;
constexpr size_t WS_END = OFF_DBG + 4096;
constexpr int LDS_BYTES = 160 * 1024;

struct Params {
    const float *x, *c, *ctx, *c_ctx, *ada_w, *ada_b, *norm_g, *ev_w_in, *ev_w_out;
    const float *s5_a_re, *s5_a_im, *s5_log_dt, *s5_b_re, *s5_b_im, *s5_c_re, *s5_c_im, *s5_d, *s5_w_glu;
    const float *da_qn_g, *da_kn_g, *da_lam, *da_subln_g, *od_w_in, *od_w_out, *gla_wa1, *gla_wa2, *gla_ba, *gla_norm_g;
    float* out; unsigned char* ws;
    int ph_lo, ph_hi;
};

__device__ __forceinline__ float bf_lo(unsigned u) { return __uint_as_float(u << 16); }
__device__ __forceinline__ float bf_hi(unsigned u) { return __uint_as_float(u & 0xffff0000u); }
__device__ __forceinline__ float bf2f(bf16_t b) { return __uint_as_float(((unsigned)b) << 16); }
__device__ __forceinline__ bf16_t f2bf(float f) { return (bf16_t)(cvt_pk_bf16(f, 0.f) & 0xffffu); }
__device__ __forceinline__ f32x16 mfma32(bf16x8 a, bf16x8 b, f32x16 c) { return __builtin_amdgcn_mfma_f32_32x32x16_bf16(a, b, c, 0, 0, 0); }
__device__ __forceinline__ f32x4 mfma16(bf16x8 a, bf16x8 b, f32x4 c) { return __builtin_amdgcn_mfma_f32_16x16x32_bf16(a, b, c, 0, 0, 0); }
__device__ __forceinline__ float shfl_from(float v, int srclane) { return __int_as_float(__builtin_amdgcn_ds_bpermute(srclane << 2, __float_as_int(v))); }
__device__ __forceinline__ float shfl_x(float v, int mask, int lane) { return shfl_from(v, lane ^ mask); }
__device__ __forceinline__ float wave_sum(float v, int lane) {
#pragma unroll
    for (int o = 32; o > 0; o >>= 1) v += shfl_x(v, o, lane);
    return v;
}
__device__ __forceinline__ bf16x8 pack8(float a0, float a1, float a2, float a3, float a4, float a5, float a6, float a7) {
    u32x4v u; u[0] = cvt_pk_bf16(a0, a1); u[1] = cvt_pk_bf16(a2, a3); u[2] = cvt_pk_bf16(a4, a5); u[3] = cvt_pk_bf16(a6, a7);
    return __builtin_bit_cast(bf16x8, u);
}
__device__ __forceinline__ float silu_f(float v) { return v * __builtin_amdgcn_rcpf(1.f + __expf(-v)); }
__device__ __forceinline__ float sigmoid_f(float v) { return __builtin_amdgcn_rcpf(1.f + __expf(-v)); }
__device__ __forceinline__ void wave_lds_sync() { asm volatile("s_waitcnt lgkmcnt(0)" ::: "memory"); __builtin_amdgcn_wave_barrier(); }
typedef __attribute__((address_space(3))) unsigned char L8;
typedef __attribute__((address_space(3))) float LF;
typedef __attribute__((address_space(3))) unsigned short LB;
#define LV(T, ptr) (*(__attribute__((address_space(3))) T*)(ptr))
#define NOINL __forceinline__

__device__ __forceinline__ unsigned long long uni64(unsigned long long v) {
    const unsigned lo = (unsigned)__builtin_amdgcn_readfirstlane((int)(unsigned)v), hi = (unsigned)__builtin_amdgcn_readfirstlane((int)(unsigned)(v >> 32));
    return ((unsigned long long)hi << 32) | lo;
}
#define LAUNDER_S(x) asm volatile("" : "+s"(x))
#define LAUNDER_G(field, T) do { unsigned long long v_ = (unsigned long long)(field); asm volatile("" : "+s"(v_)); field = (T*)(__attribute__((address_space(1))) T*)v_; } while (0)
__device__ __forceinline__ Params load_params(const Params* gp) {
    Params p = *gp;
    LAUNDER_G(p.x, const float); LAUNDER_G(p.c, const float); LAUNDER_G(p.ctx, const float); LAUNDER_G(p.c_ctx, const float); LAUNDER_G(p.ada_w, const float); LAUNDER_G(p.ada_b, const float);
    LAUNDER_G(p.norm_g, const float); LAUNDER_G(p.ev_w_in, const float); LAUNDER_G(p.ev_w_out, const float);
    LAUNDER_G(p.s5_a_re, const float); LAUNDER_G(p.s5_a_im, const float); LAUNDER_G(p.s5_log_dt, const float); LAUNDER_G(p.s5_b_re, const float); LAUNDER_G(p.s5_b_im, const float);
    LAUNDER_G(p.s5_c_re, const float); LAUNDER_G(p.s5_c_im, const float); LAUNDER_G(p.s5_d, const float); LAUNDER_G(p.s5_w_glu, const float);
    LAUNDER_G(p.da_qn_g, const float); LAUNDER_G(p.da_kn_g, const float); LAUNDER_G(p.da_lam, const float); LAUNDER_G(p.da_subln_g, const float); LAUNDER_G(p.od_w_in, const float); LAUNDER_G(p.od_w_out, const float);
    LAUNDER_G(p.gla_wa1, const float); LAUNDER_G(p.gla_wa2, const float); LAUNDER_G(p.gla_ba, const float); LAUNDER_G(p.gla_norm_g, const float);
    LAUNDER_G(p.out, float); LAUNDER_G(p.ws, unsigned char);
    return p;
}
__device__ __forceinline__ L8* uni_lds(L8* q) { return (L8*)(unsigned long long)(unsigned)__builtin_amdgcn_readfirstlane((int)(unsigned)(unsigned long long)q); }
#define PHASE_ENTRY const Params p = load_params(gp); LAUNDER_S(L)

__device__ __forceinline__ void aux_layer(const Params& p, int Lw, int part, int nparts, L8* smem, int what  ) {
    const int tid = tidx();
    LF* lds = (LF*)smem;
    const int oddw = Lw & 1, jw = Lw >> 1;
    const int ntile = (what & 1) ? 3072 + 1024 + (oddw ? 0 : 256) : 0;
    for (int t = part; t < ntile; t += nparts) {
        const float* W; bf16_t* Wt; int K, N, tk, tn;
        if (t < 3072) { tk = t / 96; tn = t % 96; K = 2048; N = 6144;
            W = (oddw ? p.od_w_in : p.ev_w_in) + (size_t)jw * 2048 * 6144; Wt = (bf16_t*)(p.ws + OFF_WTIN + (size_t)Lw * SZ_WTIN1); }
        else if (t < 4096) { const int t2 = t - 3072; tk = t2 / 32; tn = t2 % 32; K = 2048; N = 2048;
            W = (oddw ? p.od_w_out : p.ev_w_out) + (size_t)jw * 2048 * 2048; Wt = (bf16_t*)(p.ws + OFF_WTOUT + (size_t)Lw * SZ_WTOUT1); }
        else { const int t3 = t - 4096; tk = t3 / 16; tn = t3 % 16; K = 1024; N = 1024;
            W = p.s5_w_glu + (size_t)jw * 1024 * 1024; Wt = (bf16_t*)(p.ws + OFF_WTGLU + (size_t)jw * SZ_WTGLU1); }
        {
            const int r = tid >> 3, c8 = (tid & 7) * 8;
            const float* src = W + (size_t)(tk * 64 + r) * N + tn * 64 + c8;
            const float4 a = *(const float4*)src, b = *(const float4*)(src + 4);
            LF* d = lds + r * 65 + c8;
            d[0] = a.x; d[1] = a.y; d[2] = a.z; d[3] = a.w; d[4] = b.x; d[5] = b.y; d[6] = b.z; d[7] = b.w;
        }
        __syncthreads();
        {
            const int n = tid >> 3, k8 = (tid & 7) * 8;
            const LF* s = lds + k8 * 65 + n;
            u32x4v o; o[0] = cvt_pk_bf16(s[0], s[65]); o[1] = cvt_pk_bf16(s[130], s[195]); o[2] = cvt_pk_bf16(s[260], s[325]); o[3] = cvt_pk_bf16(s[390], s[455]);
            *(u32x4v*)(Wt + (size_t)(tn * 64 + n) * K + tk * 64 + k8) = o;
        }
        __syncthreads();
    }
    if (oddw && (what & 1)) {
        bf16_t* Wt = (bf16_t*)(p.ws + OFF_WTIN + (size_t)Lw * SZ_WTIN1);
        for (int idx = part * 512 + tid; idx < 256 * 2048; idx += nparts * 512) {
            const int rr = idx / 2048, k = idx % 2048;
            float v = 0.f;
            if (rr < 32) { const int d = rr >> 4, n = rr & 15; v = p.gla_wa1[((size_t)(jw * 2 + d) * 2048 + k) * 16 + n]; }
            Wt[(size_t)(6144 + rr) * 2048 + k] = f2bf(v);
        }
    }
    if (!(what & 2)) return;
    __syncthreads();
    for (int i = tid; i < 5 * 2048; i += 512) { const int r = i >> 11, k = i & 2047; const float v = r < 4 ? p.c[r * 2048 + k] : p.c_ctx[k]; lds[i] = v / (1.f + expf(-v)); }
    __syncthreads();
    LF* red = lds + 5 * 2048;
    float* mod = (float*)(p.ws + OFF_MOD);
    for (int s = part; s < 96; s += nparts) {
        const int n0 = s * 64, col = (tid & 31) * 2, ks = tid >> 5;
        const float* w = p.ada_w + (size_t)Lw * 2048 * 6144 + n0 + col;
        float a[5][2];
#pragma unroll
        for (int r = 0; r < 5; ++r) { a[r][0] = 0.f; a[r][1] = 0.f; }
#pragma unroll 1
        for (int k0 = ks; k0 < 2048; k0 += 256) {
            f32x2v wv[16];
#pragma unroll
            for (int u = 0; u < 16; ++u) wv[u] = *(const f32x2v*)(w + (size_t)(k0 + 16 * u) * 6144);
#pragma unroll
            for (int u = 0; u < 16; ++u) {
                const int k = k0 + 16 * u;
#pragma unroll
                for (int r = 0; r < 5; ++r) { const float sv = lds[r * 2048 + k]; a[r][0] += sv * wv[u][0]; a[r][1] += sv * wv[u][1]; }
            }
        }
#pragma unroll
        for (int r = 0; r < 5; ++r) { red[(ks * 5 + r) * 64 + col] = a[r][0]; red[(ks * 5 + r) * 64 + col + 1] = a[r][1]; }
        __syncthreads();
        if (tid < 320) {
            const int r = tid >> 6, c2 = tid & 63; float sum = 0.f;
#pragma unroll
            for (int q = 0; q < 16; ++q) sum += red[(q * 5 + r) * 64 + c2];
            mod[(size_t)(Lw * 5 + r) * 6144 + n0 + c2] = sum + p.ada_b[Lw * 6144 + n0 + c2];
        }
        __syncthreads();
    }
}

__device__ NOINL void phase_prologue(const Params* gp, int L, L8* smem) {
    PHASE_ENTRY;
    const int tid = tidx();
    if (bidx() == 0) {
        float* rope = (float*)(p.ws + OFF_ROPE);
        for (int idx = tid; idx < 1024; idx += 512) {
            const int pos = idx >> 4, i = idx & 15;
            const float inv = powf(10000.0f, -(float)i / 16.0f);
            const float ang = (float)pos * inv;
            rope[idx * 2] = cosf(ang); rope[idx * 2 + 1] = sinf(ang);
        }
    }
    aux_layer(p, 0, bidx(), gdim(), smem, 3);
}

__device__ NOINL void phase_norm(const Params* gp, int L, L8* smem) {
    PHASE_ENTRY;
    const int wave = tidx() >> 6, lane = tidx() & 63;
    const float* g = p.norm_g + L * 2048;
    const float* xbuf = (const float*)(p.ws + OFF_XBUF);
    bf16_t* h = (bf16_t*)(p.ws + OFF_H);
    const float* mod = (const float*)(p.ws + OFF_MOD);
    const int step = gdim() * 8;
    int row = bidx() * 8 + wave;
#define NORM_XPTR(r_) ((L == 0) ? ((r_) < NLAT ? p.x + (size_t)(r_) * 2048 : p.ctx + (size_t)((r_) - NLAT) * 2048) : xbuf + (size_t)(r_) * 2048)
    float4 vn[8];
    if (row < NROW) { const float* xr = NORM_XPTR(row);
#pragma unroll
        for (int i = 0; i < 8; ++i) vn[i] = *(const float4*)(xr + i * 256 + lane * 4); }
    for (; row < NROW; row += step) {
        const int mrow = row < NLAT ? (row >> 11) : 4;
        const float* md = mod + (size_t)(L * 5 + mrow) * 6144;
        float4 v[8], gg[8], sh[8], sc[8];
#pragma unroll
        for (int i = 0; i < 8; ++i) { const int c = i * 256 + lane * 4; v[i] = vn[i]; gg[i] = *(const float4*)(g + c); sh[i] = *(const float4*)(md + c); sc[i] = *(const float4*)(md + 2048 + c); }
        { const int nr = (row + step < NROW) ? row + step : row; const float* xr = NORM_XPTR(nr);
#pragma unroll
            for (int i = 0; i < 8; ++i) vn[i] = *(const float4*)(xr + i * 256 + lane * 4); }
        float ss = 0.f;
#pragma unroll
        for (int i = 0; i < 8; ++i) ss += v[i].x * v[i].x + v[i].y * v[i].y + v[i].z * v[i].z + v[i].w * v[i].w;
        ss = wave_sum(ss, lane);
        const float rstd = rsqrtf(ss * (1.f / 2048.f) + 1e-6f);
#pragma unroll
        for (int i = 0; i < 8; ++i) {
            const int c = i * 256 + lane * 4;
            const float o0 = (v[i].x * rstd * gg[i].x) * (1.f + sc[i].x) + sh[i].x, o1 = (v[i].y * rstd * gg[i].y) * (1.f + sc[i].y) + sh[i].y;
            const float o2 = (v[i].z * rstd * gg[i].z) * (1.f + sc[i].z) + sh[i].z, o3 = (v[i].w * rstd * gg[i].w) * (1.f + sc[i].w) + sh[i].w;
            u32x2 o; o[0] = cvt_pk_bf16(o0, o1); o[1] = cvt_pk_bf16(o2, o3);
            *(u32x2*)(h + (size_t)row * 2048 + c) = o;
        }
    }
#undef NORM_XPTR
}

struct EpiIn {
    static constexpr bool PERM = true, AFTER_DRAIN = false;
    bf16_t* P1; bf16_t* vT; float* rbuf; int odd; L8* tl;
    __device__ __forceinline__ void operator()(const f32x4 (&acc)[2][2][4][2], const pg8::Unit& u, int wr, int wc, int fr, int fq) const {
        const int row0 = u.pm * 256 + wr * 64 + fr, colt = u.pn * 256;
        const bool isr = colt >= 6144;
        const bool isv = odd ? (colt >= 2048 && colt < 4096) : (colt >= 4096 && colt < 5120);
        if (isr) {
            if (wc == 0) {
#pragma unroll
                for (int ai = 0; ai < 2; ++ai)
#pragma unroll
                    for (int m = 0; m < 4; ++m) { float* rp = rbuf + (size_t)(row0 + ai * 128 + m * 16) * 32 + 8 * fq;
                        *(f32x4*)rp = acc[ai][0][m][0]; *(f32x4*)(rp + 4) = acc[ai][0][m][1]; }
            }
        } else if (isv) {
            const int lane = fq * 16 + fr;
            LB* T = (LB*)(tl + (wr * 4 + wc) * 2304);
            const int cl_r = lane >> 2, rg = lane & 3;
#pragma unroll
            for (int ai = 0; ai < 2; ++ai) {
                const int rbase = u.pm * 256 + ai * 128 + wr * 64;
                size_t gbase; int estride;
                if (odd) { gbase = ((size_t)(rbase >> 6) * 2048) * 64; estride = 64; }
                else { int b, key; if (rbase < NLAT) { b = rbase >> 11; key = 256 + (rbase & 2047); } else { b = (rbase - NLAT) >> 8; key = (rbase - NLAT) & 255; }
                    gbase = (size_t)b * 8 * 128 * 2304 + key; estride = 2304; }
#pragma unroll
                for (int bj = 0; bj < 2; ++bj)
#pragma unroll
                    for (int n = 0; n < 2; ++n) {
                        const int cbase = (colt - (odd ? 2048 : 4096)) + bj * 128 + wc * 32 + 4 * n;
#pragma unroll
                        for (int m = 0; m < 4; ++m)
#pragma unroll
                            for (int e = 0; e < 4; ++e) T[(4 * fq + e) * 72 + 16 * m + fr] = f2bf(acc[ai][bj][m][n][e]);
                        wave_lds_sync();
                        const int cv = cbase + 8 * (cl_r >> 2) + (cl_r & 3);
#pragma unroll
                        for (int h = 0; h < 2; ++h) { const int g = rg + 4 * h;
                            const u32x4v v = LV(const u32x4v, T + cl_r * 72 + 8 * g);
                            *(u32x4v*)(vT + gbase + (size_t)cv * estride + 8 * g) = v; }
                        wave_lds_sync();
                    }
            }
        } else {
#pragma unroll
            for (int ai = 0; ai < 2; ++ai)
#pragma unroll
                for (int m = 0; m < 4; ++m) { bf16_t* rp = P1 + (size_t)(row0 + ai * 128 + m * 16) * N1 + colt + wc * 32 + 8 * fq;
#pragma unroll
                    for (int bj = 0; bj < 2; ++bj) { const f32x4 v0 = acc[ai][bj][m][0], v1 = acc[ai][bj][m][1];
                        u32x4v o; o[0] = cvt_pk_bf16(v0[0], v0[1]); o[1] = cvt_pk_bf16(v0[2], v0[3]); o[2] = cvt_pk_bf16(v1[0], v1[1]); o[3] = cvt_pk_bf16(v1[2], v1[3]);
                        *(u32x4v*)(rp + bj * 128) = o; } }
        }
    }
};
struct EpiGlu {
    static constexpr bool PERM = true, AFTER_DRAIN = false;
    const bf16_t* gbuf; const bf16_t* P1; bf16_t* merged;
    __device__ __forceinline__ void operator()(const f32x4 (&acc)[2][2][4][2], const pg8::Unit& u, int wr, int wc, int fr, int fq) const {
        const int row0 = u.pm * 256 + wr * 64 + fr, col0 = u.pn * 256 + wc * 32 + 8 * fq;
#pragma unroll
        for (int ai = 0; ai < 2; ++ai)
#pragma unroll
            for (int m = 0; m < 4; ++m) { const int row = row0 + ai * 128 + m * 16;
#pragma unroll
                for (int bj = 0; bj < 2; ++bj) { const int col = col0 + bj * 128;
                    const u32x4v g8 = *(const u32x4v*)(gbuf + (size_t)row * 1024 + col), z8 = *(const u32x4v*)(P1 + (size_t)row * N1 + 1024 + col);
                    u32x4v o;
#pragma unroll
                    for (int e = 0; e < 4; ++e) { const float a0 = acc[ai][bj][m][e >> 1][(e & 1) * 2], a1 = acc[ai][bj][m][e >> 1][(e & 1) * 2 + 1];
                        const float r0 = bf_lo(g8[e]) * sigmoid_f(a0) * silu_f(bf_lo(z8[e])), r1 = bf_hi(g8[e]) * sigmoid_f(a1) * silu_f(bf_hi(z8[e]));
                        o[e] = cvt_pk_bf16(r0, r1); }
                    *(u32x4v*)(merged + (size_t)row * 2048 + col) = o; } }
    }
};
struct EpiOut {
    static constexpr bool PERM = false, AFTER_DRAIN = false;
    const float* xin_lat; const float* xin_ctx; float* xout_lat; float* xout_ctx; const float* mod;
    __device__ __forceinline__ void operator()(const f32x4 (&acc)[2][2][4][2], const pg8::Unit& u, int wr, int wc, int fr, int fq) const {
        const int row0 = u.pm * 256 + wr * 64 + fr, col0 = u.pn * 256 + wc * 32 + 4 * fq;
        const int mrow = (u.pm < 32) ? (u.pm >> 3) : 4;
        const float* gp = mod + (size_t)mrow * 6144 + 4096 + col0;
        f32x4 gv[2][2];
#pragma unroll
        for (int bj = 0; bj < 2; ++bj)
#pragma unroll
            for (int n = 0; n < 2; ++n) gv[bj][n] = *(const f32x4*)(gp + bj * 128 + n * 16);
#pragma unroll
        for (int ai = 0; ai < 2; ++ai)
#pragma unroll
            for (int m = 0; m < 4; ++m) { const int row = row0 + ai * 128 + m * 16;
                const float* xi = (row < NLAT) ? xin_lat + (size_t)row * 2048 : xin_ctx + (size_t)(row - NLAT) * 2048;
                float* xo = (row < NLAT) ? xout_lat + (size_t)row * 2048 : xout_ctx + (size_t)(row - NLAT) * 2048;
#pragma unroll
                for (int bj = 0; bj < 2; ++bj)
#pragma unroll
                    for (int n = 0; n < 2; ++n) { const int c = col0 + bj * 128 + n * 16;
                        const f32x4 xv = *(const f32x4*)(xi + c);
                        *(f32x4*)(xo + c) = xv + gv[bj][n] * acc[ai][bj][m][n]; } }
    }
};

template <class Epi> __device__ __forceinline__ void run_gemm(L8* smem, const bf16_t* A, const bf16_t* Bt, int M, int N, int K, const Epi& E) {
    pg8::Gemm g{A, Bt, M, N, K};
    pg8::StaticOrder S; S.init(M, N, (int)gdim(), (int)bidx());
    pg8::gemm_phase<Epi, pg8::StaticOrder, false>(smem, g, S, E, nullptr);
    __syncthreads();
}

__device__ __forceinline__ void s5_stream(const Params& p, int j, int b, int g, int d, L8* lds) {
    const int lane = tidx() & 63, r = lane & 31, hh = lane >> 5, cn = lane & 15, q = lane >> 4;
    LF* BU = (LF*)lds;
    LB* Hs = (LB*)(lds + 64 * 132 * 4);
    const bf16_t* P1 = (const bf16_t*)(p.ws + OFF_P1);
    float* ybuf = (float*)(p.ws + OFF_YBUF);
    const int pd = (j * 2 + d) * 64 + g;
    const float are = p.s5_a_re[pd * 64 + lane], aim = p.s5_a_im[pd * 64 + lane];
    const float dt = expf(p.s5_log_dt[pd]);
    const float mag = expf(are * dt), ang = aim * dt;
    float sn, cs; sincosf(ang, &sn, &cs);
    const float lbr = mag * cs, lbi = mag * sn;
    const float nr = lbr - 1.f, ni = lbi, den = are * are + aim * aim;
    const float fre = (nr * are + ni * aim) / den, fim = (ni * are - nr * aim) / den;
    bf16x8 Bf[4];
#pragma unroll
    for (int nt = 0; nt < 4; ++nt) {
        const int ps = 32 * (nt >> 1) + r;
        const float fr_ = shfl_from(fre, ps), fi_ = shfl_from(fim, ps);
        const float* bre = p.s5_b_re + ((size_t)pd * 64 + ps) * 16 + 8 * hh;
        const float* bim = p.s5_b_im + ((size_t)pd * 64 + ps) * 16 + 8 * hh;
        const float4 r0 = *(const float4*)bre, r1 = *(const float4*)(bre + 4), i0 = *(const float4*)bim, i1 = *(const float4*)(bim + 4);
        const float ca = fr_, cb = (nt & 1) ? fi_ : -fi_;
        const float4 x0 = (nt & 1) ? i0 : r0, x1 = (nt & 1) ? i1 : r1, y0 = (nt & 1) ? r0 : i0, y1 = (nt & 1) ? r1 : i1;
        Bf[nt] = pack8(ca * x0.x + cb * y0.x, ca * x0.y + cb * y0.y, ca * x0.z + cb * y0.z, ca * x0.w + cb * y0.w,
                       ca * x1.x + cb * y1.x, ca * x1.y + cb * y1.y, ca * x1.z + cb * y1.z, ca * x1.w + cb * y1.w);
    }
    bf16x8 Cf[4];
#pragma unroll
    for (int ks = 0; ks < 4; ++ks) {
        const size_t off = ((size_t)pd * 16 + cn) * 64 + 16 * ks + 4 * q;
        const float4 c0 = *(const float4*)(p.s5_c_re + off), c1 = *(const float4*)(p.s5_c_im + off);
        Cf[ks] = pack8(c0.x, -c1.x, c0.y, -c1.y, c0.z, -c1.z, c0.w, -c1.w);
    }
    f32x2v hh2 = {0.f, 0.f};
    const f32x2v lbrr = {lbr, lbr}, lbii = {-lbi, lbi};
#define S5_ROWBASE(cq_) (((cq_) < 4) ? (NLAT + b * 256 + (d ? 3 - (cq_) : (cq_)) * 64) : (b * 2048 + (d ? 35 - (cq_) : (cq_) - 4) * 64))
    bf16x8 An[2];
    {
        const int rb0 = S5_ROWBASE(0);
#pragma unroll
        for (int mt = 0; mt < 2; ++mt) { const int s = 32 * mt + r, tok = d ? 63 - s : s; An[mt] = *(const bf16x8*)(P1 + (size_t)(rb0 + tok) * N1 + g * 16 + 8 * hh); }
    }
    for (int cq = 0; cq < 36; ++cq) {
        const int rowbase = S5_ROWBASE(cq);
        const bf16x8 A0 = An[0], A1 = An[1];
        if (cq + 1 < 36) {
            const int rbn = S5_ROWBASE(cq + 1);
#pragma unroll
            for (int mt = 0; mt < 2; ++mt) { const int s = 32 * mt + r, tok = d ? 63 - s : s; An[mt] = *(const bf16x8*)(P1 + (size_t)(rbn + tok) * N1 + g * 16 + 8 * hh); }
        }
#pragma unroll
        for (int mt = 0; mt < 2; ++mt) {
#pragma unroll
            for (int pr = 0; pr < 2; ++pr) {
                f32x16 accR, accI;
#pragma unroll
                for (int i = 0; i < 16; ++i) { accR[i] = 0.f; accI[i] = 0.f; }
                accR = mfma32(mt ? A1 : A0, Bf[2 * pr], accR);
                accI = mfma32(mt ? A1 : A0, Bf[2 * pr + 1], accI);
#pragma unroll
                for (int i = 0; i < 16; ++i) LV(f32x2v, BU + (32 * mt + (i & 3) + 8 * (i >> 2) + 4 * hh) * 132 + 2 * (32 * pr + r)) = (f32x2v){accR[i], accI[i]};
            }
        }
        wave_lds_sync();
#pragma unroll 1
        for (int s0 = 0; s0 < 64; s0 += 16) {
            f32x2v bu[16];
#pragma unroll
            for (int k = 0; k < 16; ++k) bu[k] = LV(const f32x2v, BU + (s0 + k) * 132 + 2 * lane);
#pragma unroll
            for (int k = 0; k < 16; ++k) {
                const f32x2v t = lbrr * hh2 + bu[k];
                hh2 = lbii * __builtin_shufflevector(hh2, hh2, 1, 0) + t;
                LV(unsigned, Hs + (s0 + k) * 136 + 2 * lane) = cvt_pk_bf16(hh2[0], hh2[1]);
            }
        }
        wave_lds_sync();
#pragma unroll
        for (int mt = 0; mt < 4; ++mt) {
            f32x4 y = {0.f, 0.f, 0.f, 0.f};
#pragma unroll
            for (int ks = 0; ks < 4; ++ks) { const bf16x8 A = LV(const bf16x8, Hs + (16 * mt + cn) * 136 + 32 * ks + 8 * q); y = mfma16(A, Cf[ks], y); }
#pragma unroll
            for (int i = 0; i < 4; ++i) { const int s = 16 * mt + 4 * q + i, tok = d ? 63 - s : s;
                ybuf[((size_t)d * NROW + rowbase + tok) * 1024 + g * 16 + cn] = y[i]; }
        }
        wave_lds_sync();
    }
#undef S5_ROWBASE
}

__device__ __forceinline__ void qk_norm_rope(const Params& p, int j, int wid, int nw) {
    const int lane = tidx() & 63, part = lane & 3;
    bf16_t* P1 = (bf16_t*)(p.ws + OFF_P1);
    const float* rope = (const float*)(p.ws + OFF_ROPE);
    for (int it = wid; it < NROW * 2; it += nw) {
        const int row = it >> 1, which = it & 1;
        bf16_t* ptr = P1 + (size_t)row * N1 + 2048 + which * 1024 + lane * 16;
        const u32x4v v0 = *(const u32x4v*)ptr, v1 = *(const u32x4v*)(ptr + 8);
        float x[16];
#pragma unroll
        for (int e = 0; e < 4; ++e) { x[2 * e] = bf_lo(v0[e]); x[2 * e + 1] = bf_hi(v0[e]); x[8 + 2 * e] = bf_lo(v1[e]); x[9 + 2 * e] = bf_hi(v1[e]); }
        float ss = 0.f;
#pragma unroll
        for (int i = 0; i < 16; ++i) ss += x[i] * x[i];
        ss += shfl_x(ss, 1, lane); ss += shfl_x(ss, 2, lane);
        const float rstd = rsqrtf(ss * (1.f / 64.f) + 1e-6f);
        const float* gn = (which ? p.da_kn_g : p.da_qn_g) + j * 64 + part * 16;
#pragma unroll
        for (int i = 0; i < 16; ++i) x[i] *= rstd * gn[i];
        if (row < NLAT) {
            const int t = row & 2047, pos = (part < 2) ? (t >> 6) : (t & 63);
            const float* rt = rope + pos * 32;
#pragma unroll
            for (int i = 0; i < 16; ++i) {
                const float px = shfl_x(x[i], 1, lane), cs = rt[2 * i], sn = rt[2 * i + 1];
                x[i] = (part & 1) ? (x[i] * cs + px * sn) : (x[i] * cs - px * sn);
            }
        }
        if (!which) {
#pragma unroll
            for (int i = 0; i < 16; ++i) x[i] *= 0.125f * 1.4426950408889634f;
        }
        u32x4v o0, o1;
#pragma unroll
        for (int e = 0; e < 4; ++e) { o0[e] = cvt_pk_bf16(x[2 * e], x[2 * e + 1]); o1[e] = cvt_pk_bf16(x[8 + 2 * e], x[9 + 2 * e]); }
        *(u32x4v*)ptr = o0; *(u32x4v*)(ptr + 8) = o1;
    }
}

__device__ NOINL void phase_s5(const Params* gp, int L, L8* smem, int do_qk) {
    PHASE_ENTRY;
    const int wave = tidx() >> 6;
    if (wave < 2) {
        for (int item = bidx(); item < 256; item += gdim()) s5_stream(p, L >> 1, item >> 6, item & 63, wave, smem + wave * 51200);
    } else if (do_qk) {
        qk_norm_rope(p, L >> 1, bidx() * 6 + wave - 2, gdim() * 6);
    }
}

__device__ __forceinline__ int claim_item(unsigned* cnt, int inst, int nitems, int& y, int& tried, L8* smem) {
    volatile LAS int* slot = (volatile LAS int*)(smem + LDS_BYTES - 8);
    const int tid = tidx();
    __syncthreads();
    if (tid < 64) {
        int got = -1;
        if (tried < 8) for (;;) {
            const unsigned c = (tid < 8) ? __hip_atomic_load(cnt + (inst * 8 + tid) * 16, __ATOMIC_RELAXED, __HIP_MEMORY_SCOPE_AGENT) : 0xffffffffu;
            const unsigned long long avail = __builtin_amdgcn_ballot_w64(tid < 8 && c < (unsigned)nitems);
            if (avail == 0ull) break;
            int pick = y;
#pragma unroll
            for (int k = 7; k >= 0; --k) { const int g = (y + k) & 7; if ((avail >> g) & 1ull) pick = g; }
            unsigned idx = 0u;
            if (tid == 0) idx = __hip_atomic_fetch_add(cnt + (inst * 8 + pick) * 16, 1u, __ATOMIC_RELAXED, __HIP_MEMORY_SCOPE_AGENT);
            idx = (unsigned)__builtin_amdgcn_readfirstlane((int)idx);
            if (idx < (unsigned)nitems) { got = (int)idx; y = pick; break; }
        }
        if (tid == 0) { slot[0] = got; slot[1] = y; }
    }
    __syncthreads();
    const int got = slot[0]; y = slot[1];
    if (got < 0) tried = 8;
    return got;
}

__device__ __forceinline__ void attn_item(const Params& p, int L, int b, int h, int qb, int isctx, float lam, float lam_init, L8* smem) {
    const int j = L >> 1, tid = tidx(), w = tid >> 6, lane = tid & 63, r = lane & 31, hh = lane >> 5;
    const int m = w >> 2, qs = w & 3;
    const bf16_t* P1 = (const bf16_t*)(p.ws + OFF_P1);
    const bf16_t* vT = (const bf16_t*)(p.ws + OFF_VT);
    bf16_t* merged = (bf16_t*)(p.ws + OFF_MERGED);
    const int qrow0 = isctx ? (NLAT + b * 256 + qb * 128) : (b * 2048 + qb * 128);
    const int myrow = qrow0 + qs * 32 + r;
    bf16x8 Bq[4];
#pragma unroll
    for (int ks = 0; ks < 4; ++ks) Bq[ks] = *(const bf16x8*)(P1 + (size_t)myrow * N1 + 2048 + h * 128 + m * 64 + 16 * ks + 8 * hh);
    f32x16 ot[4];
#pragma unroll
    for (int dt = 0; dt < 4; ++dt)
#pragma unroll
        for (int i = 0; i < 16; ++i) ot[dt][i] = 0.f;
    float mrun = 0.f, lrun = 0.f;
    const int nkt = isctx ? 4 : 36;
    const int krow = tid >> 3, kseg = tid & 7, vrow = tid >> 2, vseg = tid & 3;
    struct TileRegs { u32x4v k0, k1, v0, v1; };
    TileRegs X, Y;
#define ATT_LOAD(R_, kt_) do { const int ktc_ = (kt_) < nkt ? (kt_) : nkt - 1; const int key_ = ktc_ * 64 + krow; const int grow_ = key_ < 256 ? (NLAT + b * 256 + key_) : (b * 2048 + key_ - 256); \
        const bf16_t* ks_ = P1 + (size_t)grow_ * N1 + 3072 + h * 128 + kseg * 16; R_.k0 = *(const u32x4v*)ks_; R_.k1 = *(const u32x4v*)(ks_ + 8); \
        const bf16_t* vs_ = vT + ((size_t)(b * 8 + h) * 128 + vrow) * 2304 + ktc_ * 64 + vseg * 16; R_.v0 = *(const u32x4v*)vs_; R_.v1 = *(const u32x4v*)(vs_ + 8); } while (0)
#define ATT_STORE(R_, buf) do { L8* kb_ = smem + (buf) * 35840 + krow * 272 + kseg * 32; LV(u32x4v, kb_) = R_.k0; LV(u32x4v, kb_ + 16) = R_.k1; \
        L8* vb_ = smem + (buf) * 35840 + 17408 + vrow * 144 + vseg * 32; \
        LV(u32x2, vb_) = (u32x2){R_.v0[0], R_.v0[1]}; LV(u32x2, vb_ + 16) = (u32x2){R_.v0[2], R_.v0[3]}; LV(u32x2, vb_ + 8) = (u32x2){R_.v1[0], R_.v1[1]}; LV(u32x2, vb_ + 24) = (u32x2){R_.v1[2], R_.v1[3]}; } while (0)
    ATT_LOAD(X, 0);
    ATT_STORE(X, 0);
    ATT_LOAD(X, 1);
    __syncthreads();
    bf16x8 Bp[4];
    auto qk_softmax = [&](const L8* Ks, const int kt) __attribute__((always_inline)) {
        f32x16 st[2];
        const float minit = -mrun;
#pragma unroll
        for (int k2 = 0; k2 < 2; ++k2) {
#pragma unroll
            for (int i = 0; i < 16; ++i) st[k2][i] = minit;
#pragma unroll
            for (int ks = 0; ks < 4; ++ks) { const bf16x8 A = LV(const bf16x8, Ks + (32 * k2 + r) * 272 + (m * 64 + 16 * ks + 8 * hh) * 2); st[k2] = mfma32(A, Bq[ks], st[k2]); }
        }
        float mx = st[0][0];
#pragma unroll
        for (int i = 0; i < 16; ++i) { mx = fmaxf(mx, st[0][i]); mx = fmaxf(mx, st[1][i]); }
        mx = fmaxf(mx, shfl_x(mx, 32, lane));
        if (__builtin_amdgcn_ballot_w64(kt == 0 || mx > 8.f) != 0ull) {
            const float delta = (kt == 0) ? mx : fmaxf(mx, 0.f);
            const float alpha = __builtin_amdgcn_exp2f(-delta);
            mrun += delta; lrun *= alpha;
#pragma unroll
            for (int dt = 0; dt < 4; ++dt)
#pragma unroll
                for (int i = 0; i < 16; ++i) ot[dt][i] *= alpha;
#pragma unroll
            for (int k2 = 0; k2 < 2; ++k2)
#pragma unroll
                for (int i = 0; i < 16; ++i) st[k2][i] -= delta;
        }
        float psum = 0.f;
#pragma unroll
        for (int k2 = 0; k2 < 2; ++k2)
#pragma unroll
            for (int i = 0; i < 16; ++i) { const float pv = __builtin_amdgcn_exp2f(st[k2][i]); st[k2][i] = pv; psum += pv; }
        lrun += psum;
#pragma unroll
        for (int k2 = 0; k2 < 2; ++k2)
#pragma unroll
            for (int s = 0; s < 2; ++s)
                Bp[2 * k2 + s] = pack8(st[k2][8 * s], st[k2][8 * s + 1], st[k2][8 * s + 2], st[k2][8 * s + 3], st[k2][8 * s + 4], st[k2][8 * s + 5], st[k2][8 * s + 6], st[k2][8 * s + 7]);
    };
    auto pv_acc = [&](const L8* Vs) __attribute__((always_inline)) {
#pragma unroll
        for (int k2 = 0; k2 < 2; ++k2)
#pragma unroll
            for (int s = 0; s < 2; ++s)
#pragma unroll
                for (int dt = 0; dt < 4; ++dt) {
                    const bf16x8 av = LV(const bf16x8, Vs + (32 * dt + r) * 144 + (2 * k2 + s) * 32 + hh * 16);
                    ot[dt] = mfma32(av, Bp[2 * k2 + s], ot[dt]);
                }
    };
    int cur = 0, prv = 2;
    auto tile_step = [&](TileRegs& Rn, TileRegs& Rl, const int kt) __attribute__((always_inline)) {
        const int nxt = (cur == 2) ? 0 : cur + 1;
        ATT_LOAD(Rl, kt + 2);
        const L8* Ks = smem + cur * 35840;
        if (m == 0) { qk_softmax(Ks, kt); pv_acc(Ks + 17408); }
        else { if (kt > 0) pv_acc(smem + prv * 35840 + 17408); qk_softmax(Ks, kt); }
        ATT_STORE(Rn, nxt);
        __syncthreads();
        prv = cur; cur = nxt;
    };
    for (int kt = 0; kt < nkt; kt += 2) { tile_step(X, Y, kt); tile_step(Y, X, kt + 1); }
    if (m == 1) pv_acc(smem + prv * 35840 + 17408);
    __syncthreads();
#undef ATT_LOAD
#undef ATT_STORE
    const float ltot = lrun + shfl_x(lrun, 32, lane);
    const float inv = 1.f / ltot;
    LF* ex = (LF*)smem;
    if (m == 1) {
#pragma unroll
        for (int dt = 0; dt < 4; ++dt)
#pragma unroll
            for (int i = 0; i < 16; ++i) { const int dv = 32 * dt + (i & 3) + 8 * (i >> 2) + 4 * hh; ex[(qs * 128 + dv) * 32 + r] = ot[dt][i] * inv; }
    }
    __syncthreads();
    if (m == 0) {
        float ssq = 0.f;
#pragma unroll
        for (int dt = 0; dt < 4; ++dt)
#pragma unroll
            for (int i = 0; i < 16; ++i) { const int dv = 32 * dt + (i & 3) + 8 * (i >> 2) + 4 * hh;
                const float o = ot[dt][i] * inv - lam * ex[(qs * 128 + dv) * 32 + r]; ot[dt][i] = o; ssq += o * o; }
        ssq += shfl_x(ssq, 32, lane);
        const float rstd = rsqrtf(ssq * (1.f / 128.f) + 1e-6f) * (1.f - lam_init);
        const float* sg = p.da_subln_g + j * 128;
        f32x4 ggv[4][4]; u32x2 zzv[4][4];
#pragma unroll
        for (int dt = 0; dt < 4; ++dt)
#pragma unroll
            for (int g4 = 0; g4 < 4; ++g4) { const int dv = 32 * dt + 8 * g4 + 4 * hh; ggv[dt][g4] = *(const f32x4*)(sg + dv); zzv[dt][g4] = *(const u32x2*)(P1 + (size_t)myrow * N1 + 5120 + h * 128 + dv); }
#pragma unroll
        for (int dt = 0; dt < 4; ++dt)
#pragma unroll
            for (int g4 = 0; g4 < 4; ++g4) {
                const int dv = 32 * dt + 8 * g4 + 4 * hh;
                const f32x4 gg = ggv[dt][g4];
                const u32x2 z = zzv[dt][g4];
                const float y0 = ot[dt][4 * g4] * rstd * gg[0] * silu_f(bf_lo(z[0])), y1 = ot[dt][4 * g4 + 1] * rstd * gg[1] * silu_f(bf_hi(z[0]));
                const float y2 = ot[dt][4 * g4 + 2] * rstd * gg[2] * silu_f(bf_lo(z[1])), y3 = ot[dt][4 * g4 + 3] * rstd * gg[3] * silu_f(bf_hi(z[1]));
                u32x2 o; o[0] = cvt_pk_bf16(y0, y1); o[1] = cvt_pk_bf16(y2, y3);
                *(u32x2*)(merged + (size_t)myrow * 2048 + 1024 + h * 128 + dv) = o;
            }
    }
    __syncthreads();
}

__device__ NOINL void phase_attn(const Params* gp, int L, L8* smem, int qinst) {
    PHASE_ENTRY;
    const int j = L >> 1, tid = tidx(), lane = tid & 63;
    {
        const float* ybuf = (const float*)(p.ws + OFF_YBUF);
        const bf16_t* P1 = (const bf16_t*)(p.ws + OFF_P1);
        bf16_t* gbuf = (bf16_t*)(p.ws + OFF_GBUF);
        const float* dsk = p.s5_d + j * 1024;
        const int gs = gdim() * 512, idx0 = bidx() * 512 + tid, c8 = (idx0 & 127) * 8;
        const float4 d0 = *(const float4*)(dsk + c8), d1 = *(const float4*)(dsk + c8 + 4);
        const float dd[8] = {d0.x, d0.y, d0.z, d0.w, d1.x, d1.y, d1.z, d1.w};
        if ((gs & 127) == 0)
        for (int idx = idx0; idx < NROW * 128; idx += 3 * gs) {
            int rows[3]; float4 a0[3], a1[3], b0[3], b1[3]; u32x4v u8[3];
#pragma unroll
            for (int u = 0; u < 3; ++u) {
                const int ix = (idx + u * gs < NROW * 128) ? idx + u * gs : idx; rows[u] = ix >> 7;
                const float* y0 = ybuf + (size_t)rows[u] * 1024 + c8; const float* y1 = y0 + (size_t)NROW * 1024;
                a0[u] = *(const float4*)y0; a1[u] = *(const float4*)(y0 + 4); b0[u] = *(const float4*)y1; b1[u] = *(const float4*)(y1 + 4);
                u8[u] = *(const u32x4v*)(P1 + (size_t)rows[u] * N1 + c8);
            }
#pragma unroll
            for (int u = 0; u < 3; ++u) {
                float y[8] = {a0[u].x + b0[u].x, a0[u].y + b0[u].y, a0[u].z + b0[u].z, a0[u].w + b0[u].w, a1[u].x + b1[u].x, a1[u].y + b1[u].y, a1[u].z + b1[u].z, a1[u].w + b1[u].w};
#pragma unroll
                for (int e = 0; e < 8; ++e) { const float uv = (e & 1) ? bf_hi(u8[u][e >> 1]) : bf_lo(u8[u][e >> 1]);
                    const float v = y[e] + dd[e] * uv, z = 0.7978845608028654f * (v + 0.044715f * v * v * v);
                    const float th = 1.f - 2.f * __builtin_amdgcn_rcpf(__expf(2.f * z) + 1.f); y[e] = 0.5f * v * (1.f + th); }
                u32x4v o; o[0] = cvt_pk_bf16(y[0], y[1]); o[1] = cvt_pk_bf16(y[2], y[3]); o[2] = cvt_pk_bf16(y[4], y[5]); o[3] = cvt_pk_bf16(y[6], y[7]);
                *(u32x4v*)(gbuf + (size_t)rows[u] * 1024 + c8) = o;
            }
        }
        else
        for (int idx = idx0; idx < NROW * 128; idx += gs) {
            const int row = idx >> 7, cc = (idx & 127) * 8;
            const float* y0 = ybuf + (size_t)row * 1024 + cc; const float* y1 = y0 + (size_t)NROW * 1024;
            const float4 a0 = *(const float4*)y0, a1 = *(const float4*)(y0 + 4), b0 = *(const float4*)y1, b1 = *(const float4*)(y1 + 4);
            const float4 e0 = *(const float4*)(dsk + cc), e1 = *(const float4*)(dsk + cc + 4);
            const u32x4v u8 = *(const u32x4v*)(P1 + (size_t)row * N1 + cc);
            float y[8] = {a0.x + b0.x + e0.x * bf_lo(u8[0]), a0.y + b0.y + e0.y * bf_hi(u8[0]), a0.z + b0.z + e0.z * bf_lo(u8[1]), a0.w + b0.w + e0.w * bf_hi(u8[1]),
                          a1.x + b1.x + e1.x * bf_lo(u8[2]), a1.y + b1.y + e1.y * bf_hi(u8[2]), a1.z + b1.z + e1.z * bf_lo(u8[3]), a1.w + b1.w + e1.w * bf_hi(u8[3])};
#pragma unroll
            for (int e = 0; e < 8; ++e) { const float v = y[e], z = 0.7978845608028654f * (v + 0.044715f * v * v * v);
                const float th = 1.f - 2.f * __builtin_amdgcn_rcpf(__expf(2.f * z) + 1.f); y[e] = 0.5f * v * (1.f + th); }
            u32x4v o; o[0] = cvt_pk_bf16(y[0], y[1]); o[1] = cvt_pk_bf16(y[2], y[3]); o[2] = cvt_pk_bf16(y[4], y[5]); o[3] = cvt_pk_bf16(y[6], y[7]);
            *(u32x4v*)(gbuf + (size_t)row * 1024 + cc) = o;
        }
    }
    const float* lv = p.da_lam + j * 256;
    const float s01 = wave_sum(lv[lane] * lv[64 + lane], lane), s23 = wave_sum(lv[128 + lane] * lv[192 + lane], lane);
    const float lam_init = 0.8f - 0.6f * expf(-0.3f * (float)L);
    const float lam = expf(s01) - expf(s23) + lam_init;
    {
        unsigned* cnt = (unsigned*)(p.ws + OFF_CNT);
        int y = (int)(xb_xcc_id() & 7u), tried = 0;
        for (;;) {
            const int idx = claim_item(cnt, qinst, 72, y, tried, smem);
            if (idx < 0) break;
            int bh, qb, isctx;
            if (idx < 64) { bh = y * 4 + (idx >> 4); qb = idx & 15; isctx = 0; }
            else { const int k = idx - 64; bh = y * 4 + (k >> 1); qb = k & 1; isctx = 1; }
            attn_item(p, L, bh >> 3, bh & 7, qb, isctx, lam, lam_init, smem);
        }
    }
}

__device__ NOINL void phase_gla_pre(const Params* gp, int L, L8* smem) {
    PHASE_ENTRY;
    const int j = L >> 1, tid = tidx(), col = tid & 255, half = tid >> 8;
    const bf16_t* P1 = (const bf16_t*)(p.ws + OFF_P1);
    const float* rbuf = (const float*)(p.ws + OFF_RBUF);
    bf16_t* qd = (bf16_t*)(p.ws + OFF_QD); bf16_t* pg = (bf16_t*)(p.ws + OFF_KD); bf16_t* ket = (bf16_t*)(p.ws + OFF_KET);
    float* dec = (float*)(p.ws + OFF_DEC);
    LB* Qs = (LB*)(smem + 8192); LB* Ks = (LB*)(smem + 8192 + 33792);
    const int wv = tid >> 6, n16 = tid & 15, q4 = (tid >> 4) & 3;
    LF* tot = (LF*)smem + 1024;
    LF* Lg = (LF*)(smem + 8192 + 2 * 33792);
    for (int it = bidx(); it < 1152; it += gdim()) {
        const int c = it >> 3, hd = (it >> 1) & 3, d = it & 1, row0 = c * 64;
        __syncthreads();
        bf16_t qraw[32], kraw[32];
#pragma unroll
        for (int tt = 0; tt < 32; ++tt) { const size_t o_ = (size_t)(row0 + half * 32 + tt) * N1 + hd * 256 + col; qraw[tt] = P1[o_]; kraw[tt] = P1[o_ + 1024]; }
        {
            bf16x8 Af[4], Bw[2];
#pragma unroll
            for (int mt = 0; mt < 4; ++mt) {
                float4 x0 = make_float4(0.f, 0.f, 0.f, 0.f), x1 = x0;
                if (q4 < 2) { const float* rp = rbuf + (size_t)(row0 + 16 * mt + n16) * 32 + d * 16 + 8 * q4; x0 = *(const float4*)rp; x1 = *(const float4*)(rp + 4); }
                Af[mt] = pack8(x0.x, x0.y, x0.z, x0.w, x1.x, x1.y, x1.z, x1.w);
            }
#pragma unroll
            for (int nn = 0; nn < 2; ++nn) {
                float wv8[8];
#pragma unroll
                for (int e = 0; e < 8; ++e) wv8[e] = (q4 < 2) ? p.gla_wa2[((size_t)(j * 2 + d) * 16 + 8 * q4 + e) * 1024 + hd * 256 + 16 * (2 * wv + nn) + n16] : 0.f;
                Bw[nn] = pack8(wv8[0], wv8[1], wv8[2], wv8[3], wv8[4], wv8[5], wv8[6], wv8[7]);
            }
#pragma unroll
            for (int mt = 0; mt < 4; ++mt)
#pragma unroll
                for (int nn = 0; nn < 2; ++nn) {
                    f32x4 acc = {0.f, 0.f, 0.f, 0.f};
                    acc = mfma16(Af[mt], Bw[nn], acc);
#pragma unroll
                    for (int i = 0; i < 4; ++i) Lg[(16 * mt + 4 * q4 + i) * 260 + 16 * (2 * wv + nn) + n16] = acc[i];
                }
        }
        const float bias = p.gla_ba[(j * 2 + d) * 1024 + hd * 256 + col];
        __syncthreads();
        float la[32]; float run = 0.f;
#pragma unroll
        for (int tt = 0; tt < 32; ++tt) {
            const int t = half * 32 + tt; const float lg = bias + Lg[t * 260 + col];
            la[tt] = (fminf(lg, 0.f) - __logf(1.f + __expf(-fabsf(lg)))) * (1.f / 16.f);
            run += la[tt];
        }
        tot[half * 256 + col] = run;
        __syncthreads();
        const float tot0 = tot[col], tot1 = tot[256 + col], bend = tot0 + tot1;
        float bcum[32];
        if (d == 0) { float a = half ? tot0 : 0.f;
#pragma unroll
            for (int tt = 0; tt < 32; ++tt) { a += la[tt]; bcum[tt] = a; } }
        else { float a = half ? 0.f : tot1;
#pragma unroll
            for (int tt = 31; tt >= 0; --tt) { a += la[tt]; bcum[tt] = a; } }
        const size_t gcol = hd * 256 + col;
        unsigned kev[16];
#pragma unroll
        for (int tp = 0; tp < 16; ++tp) {
            float ke2[2];
#pragma unroll
            for (int e = 0; e < 2; ++e) {
                const int tt = 2 * tp + e, row = row0 + half * 32 + tt;
                const float qv = bf2f(qraw[tt]), kv = bf2f(kraw[tt]);
                const bf16_t qb_ = f2bf(qv * 0.0625f * __expf(bcum[tt])), kb_ = f2bf(kv * __expf(-bcum[tt]));
                qd[((size_t)d * NROW + row) * 1024 + gcol] = qb_;
                Qs[(half * 32 + tt) * 264 + col] = qb_; Ks[(half * 32 + tt) * 264 + col] = kb_;
                ke2[e] = kv * __expf(bend - bcum[tt]);
            }
            kev[tp] = cvt_pk_bf16(ke2[0], ke2[1]);
        }
        bf16_t* kp = ket + (((size_t)d * 144 + c) * 1024 + gcol) * 64 + half * 32;
#pragma unroll
        for (int e = 0; e < 4; ++e) { u32x4v o = {kev[4 * e], kev[4 * e + 1], kev[4 * e + 2], kev[4 * e + 3]}; *(u32x4v*)(kp + 8 * e) = o; }
        if (half == 0) dec[((size_t)d * 144 + c) * 1024 + gcol] = __expf(bend);
        __syncthreads();
        {
            const int mt = wv >> 1, nb = 2 * (wv & 1);
            f32x4 sc[2] = {(f32x4){0.f, 0.f, 0.f, 0.f}, (f32x4){0.f, 0.f, 0.f, 0.f}};
#pragma unroll
            for (int ks = 0; ks < 8; ++ks) {
                const bf16x8 A = LV(const bf16x8, Ks + (16 * mt + n16) * 264 + 32 * ks + 8 * q4);
#pragma unroll
                for (int nn = 0; nn < 2; ++nn) { const bf16x8 B = LV(const bf16x8, Qs + (16 * (nb + nn) + n16) * 264 + 32 * ks + 8 * q4); sc[nn] = mfma16(A, B, sc[nn]); }
            }
            bf16_t* pp = pg + (((size_t)d * 144 + c) * 4 + hd) * 4096;
#pragma unroll
            for (int nn = 0; nn < 2; ++nn) {
                const int t = 16 * (nb + nn) + n16, s0 = 16 * mt + 4 * q4;
                float v[4];
#pragma unroll
                for (int i = 0; i < 4; ++i) { const int s = s0 + i; const bool keep = d ? (t <= s) : (t >= s); v[i] = keep ? sc[nn][i] : 0.f; }
                u32x2 o; o[0] = cvt_pk_bf16(v[0], v[1]); o[1] = cvt_pk_bf16(v[2], v[3]);
                *(u32x2*)(pp + t * 64 + s0) = o;
            }
        }
    }
}

__device__ NOINL void phase_gla(const Params* gp, int L, L8* smem, int qinst) {
    PHASE_ENTRY;
    const int tid = tidx(), w = tid >> 6, lane = tid & 63, n16 = lane & 15, q4 = lane >> 4;
    const bf16_t* qd = (const bf16_t*)(p.ws + OFF_QD); const bf16_t* pg = (const bf16_t*)(p.ws + OFF_KD); const bf16_t* ket = (const bf16_t*)(p.ws + OFF_KET);
    const bf16_t* vTg = (const bf16_t*)(p.ws + OFF_VT);
    const float* decg = (const float*)(p.ws + OFF_DEC);
    float* obuf = (float*)(p.ws + OFF_OBUF);
    L8* Qd = smem; L8* Kd = smem + 33792; L8* KeT = smem + 67584; L8* VTs = smem + 104448;
    L8* STs = smem + 113664; L8* Ps = smem + 147456; LF* decl = (LF*)(smem + 156672);
    const int r8 = tid >> 3, s8 = tid & 7, dk2 = tid >> 1, sg2 = tid & 1;
    unsigned* cnt = (unsigned*)(p.ws + OFF_CNT);
    int qy = (int)(xb_xcc_id() & 7u), qtried = 0;
    for (;;) {
        const int qidx = claim_item(cnt, qinst, 32, qy, qtried, smem);
        if (qidx < 0) break;
        const int stream = qy * 4 + (qidx >> 3), dvs = qidx & 7;
        const int b = stream >> 3, hd = (stream >> 1) & 3, d = stream & 1;
        f32x4 S[2][4];
#pragma unroll
        for (int mt = 0; mt < 2; ++mt)
#pragma unroll
            for (int nt = 0; nt < 4; ++nt) S[mt][nt] = (f32x4){0.f, 0.f, 0.f, 0.f};
        struct GlaRegs { u32x4v rq[4], rp, re[4], rv; float rdec; };
        GlaRegs R0, R1; R0.rdec = 0.f; R1.rdec = 0.f;
#define GLA_CHUNK(cq_, c_, no_) const int ic_ = (cq_) < 4, ix_ = ic_ ? (cq_) : (cq_) - 4, ns_ = ic_ ? 4 : 32, cs_ = d ? (ns_ - 1 - ix_) : ix_; \
        const int c_ = ic_ ? (128 + b * 4 + cs_) : (b * 32 + cs_); const bool no_ = !(ic_ && L == 3)
#define GLA_LOAD(R_, cq_) do { GLA_CHUNK(cq_, cc_, noo_); const int rr0_ = cc_ * 64; \
        if (noo_) { const bf16_t* src = qd + ((size_t)d * NROW + rr0_ + r8) * 1024 + hd * 256 + s8 * 8; _Pragma("unroll") for (int e = 0; e < 4; ++e) R_.rq[e] = *(const u32x4v*)(src + 64 * e); } \
        if (noo_) R_.rp = *(const u32x4v*)(pg + (((size_t)d * 144 + cc_) * 4 + hd) * 4096 + r8 * 64 + s8 * 8); \
        { const bf16_t* src = ket + (((size_t)d * 144 + cc_) * 1024 + hd * 256 + 32 * w + n16) * 64 + 8 * q4; _Pragma("unroll") for (int e = 0; e < 4; ++e) R_.re[e] = *(const u32x4v*)(src + (e >> 1) * 1024 + (e & 1) * 32); } \
        R_.rv = *(const u32x4v*)(vTg + ((size_t)cc_ * 2048 + hd * 512 + dvs * 64 + r8) * 64 + s8 * 8); \
        if (tid < 256) R_.rdec = decg[((size_t)d * 144 + cc_) * 1024 + hd * 256 + tid]; } while (0)
        GLA_LOAD(R0, 0); GLA_LOAD(R1, 1);
#ifdef GLA_PROBE
        long long a01 = 0, a12 = 0, a23 = 0, a30 = 0, tprev = clock64();
#endif
        auto chunk_step = [&](GlaRegs& R, const int cq) __attribute__((always_inline)) {
            GLA_CHUNK(cq, c, need_o);
            const int row0 = c * 64;
#ifdef GLA_PROBE
            const long long t0 = clock64(); a30 += t0 - tprev;
#endif
            __syncthreads();
#pragma unroll
            for (int mt = 0; mt < 2; ++mt)
#pragma unroll
                for (int nt = 0; nt < 4; ++nt) { u32x2 o; o[0] = cvt_pk_bf16(S[mt][nt][0], S[mt][nt][1]); o[1] = cvt_pk_bf16(S[mt][nt][2], S[mt][nt][3]);
                    LV(u32x2, STs + (16 * nt + n16) * 528 + (32 * w + 16 * mt + 4 * q4) * 2) = o; }
            if (need_o) {
#pragma unroll
                for (int e = 0; e < 4; ++e) LV(u32x4v, Qd + r8 * 528 + s8 * 16 + 128 * e) = R.rq[e]; }
            if (need_o) LV(u32x4v, Ps + r8 * 144 + s8 * 16) = R.rp;
            LV(u32x4v, VTs + r8 * 144 + s8 * 16) = R.rv;
            if (tid < 256) decl[tid] = R.rdec;
            __syncthreads();
#ifdef GLA_PROBE
            const long long t1 = clock64(); a01 += t1 - t0;
#endif
            if (need_o) {
                const int mt = w >> 1, nb = 2 * (w & 1);
                {
                    f32x4 oa[2] = {(f32x4){0.f, 0.f, 0.f, 0.f}, (f32x4){0.f, 0.f, 0.f, 0.f}};
#pragma unroll
                    for (int ks = 0; ks < 2; ++ks) {
                        const bf16x8 A = LV(const bf16x8, Ps + (16 * mt + n16) * 144 + (32 * ks + 8 * q4) * 2);
#pragma unroll
                        for (int nn = 0; nn < 2; ++nn) { const bf16x8 B = LV(const bf16x8, VTs + (16 * (nb + nn) + n16) * 144 + (32 * ks + 8 * q4) * 2); oa[nn] = mfma16(A, B, oa[nn]); }
                    }
#pragma unroll
                    for (int ks = 0; ks < 8; ++ks) {
                        const bf16x8 A = LV(const bf16x8, Qd + (16 * mt + n16) * 528 + (32 * ks + 8 * q4) * 2);
#pragma unroll
                        for (int nn = 0; nn < 2; ++nn) { const bf16x8 B = LV(const bf16x8, STs + (16 * (nb + nn) + n16) * 528 + (32 * ks + 8 * q4) * 2); oa[nn] = mfma16(A, B, oa[nn]); }
                    }
#pragma unroll
                    for (int nn = 0; nn < 2; ++nn)
#pragma unroll
                        for (int i = 0; i < 4; ++i)
                            obuf[((size_t)d * NROW + row0 + 16 * mt + 4 * q4 + i) * 2048 + hd * 512 + dvs * 64 + 16 * (nb + nn) + n16] = oa[nn][i];
                }
            }
#ifdef GLA_PROBE
            const long long t2 = clock64(); a12 += t2 - t1;
#endif
#pragma unroll
            for (int mt = 0; mt < 2; ++mt) { const f32x4 dv4 = LV(const f32x4, decl + 32 * w + 16 * mt + 4 * q4);
#pragma unroll
                for (int nt = 0; nt < 4; ++nt) S[mt][nt] *= dv4; }
#pragma unroll
            for (int ks = 0; ks < 2; ++ks) {
                bf16x8 A[2];
#pragma unroll
                for (int mt = 0; mt < 2; ++mt) A[mt] = __builtin_bit_cast(bf16x8, R.re[2 * mt + ks]);
#pragma unroll
                for (int nt = 0; nt < 4; ++nt) { const bf16x8 B = LV(const bf16x8, VTs + (16 * nt + n16) * 144 + (32 * ks + 8 * q4) * 2);
#pragma unroll
                    for (int mt = 0; mt < 2; ++mt) S[mt][nt] = mfma16(A[mt], B, S[mt][nt]); }
            }
            if (cq + 2 < 36) GLA_LOAD(R, cq + 2);
#ifdef GLA_PROBE
            asm volatile("" :: "v"(S[0][0][0]), "v"(S[1][3][3]));
            tprev = clock64(); a23 += tprev - t2;
#endif
        };
        for (int cq = 0; cq < 36; cq += 2) { chunk_step(R0, cq); chunk_step(R1, cq + 1); }
#ifdef GLA_PROBE
        if (bidx() == 0 && tid == 0 && L == 1) { float* dbg = (float*)(p.ws + OFF_DBG); dbg[0] = (float)a01 / 36.f; dbg[1] = (float)a12 / 36.f; dbg[2] = (float)a23 / 36.f; dbg[3] = (float)a30 / 36.f; }
#endif
#undef GLA_LOAD
#undef GLA_CHUNK
    }
}

__device__ NOINL void phase_gla_finish(const Params* gp, int L, L8* smem) {
    PHASE_ENTRY;
    const int j = L >> 1, wave = tidx() >> 6, lane = tidx() & 63;
    const float* obuf = (const float*)(p.ws + OFF_OBUF);
    const bf16_t* P1 = (const bf16_t*)(p.ws + OFF_P1);
    bf16_t* merged = (bf16_t*)(p.ws + OFF_MERGED);
    const float* gn = p.gla_norm_g + j * 512;
    const int nrows = (L == 3) ? NLAT : NROW;
    const float4 g0 = *(const float4*)(gn + lane * 8), g1 = *(const float4*)(gn + lane * 8 + 4);
    const float gg[8] = {g0.x, g0.y, g0.z, g0.w, g1.x, g1.y, g1.z, g1.w};
    const int stride = gdim() * 8, total = nrows * 4;
    for (int it = bidx() * 8 + wave; it < total; it += 2 * stride) {
        int itx[2]; itx[0] = it; itx[1] = (it + stride < total) ? it + stride : it;
        float4 a0[2], a1[2], b0[2], b1[2]; u32x4v z8[2];
#pragma unroll
        for (int u = 0; u < 2; ++u) {
            const int row = itx[u] >> 2, c0 = (itx[u] & 3) * 512 + lane * 8;
            const float* o0 = obuf + (size_t)row * 2048 + c0; const float* o1 = o0 + (size_t)NROW * 2048;
            a0[u] = *(const float4*)o0; a1[u] = *(const float4*)(o0 + 4); b0[u] = *(const float4*)o1; b1[u] = *(const float4*)(o1 + 4);
            z8[u] = *(const u32x4v*)(P1 + (size_t)row * N1 + 4096 + c0);
        }
#pragma unroll
        for (int u = 0; u < 2; ++u) {
            const int row = itx[u] >> 2, c0 = (itx[u] & 3) * 512 + lane * 8;
            float v[8] = {a0[u].x + b0[u].x, a0[u].y + b0[u].y, a0[u].z + b0[u].z, a0[u].w + b0[u].w, a1[u].x + b1[u].x, a1[u].y + b1[u].y, a1[u].z + b1[u].z, a1[u].w + b1[u].w};
            float ss = 0.f;
#pragma unroll
            for (int e = 0; e < 8; ++e) ss += v[e] * v[e];
            ss = wave_sum(ss, lane);
            const float rstd = rsqrtf(ss * (1.f / 512.f) + 1e-6f);
            float y[8];
#pragma unroll
            for (int e = 0; e < 8; ++e) { const float z = (e & 1) ? bf_hi(z8[u][e >> 1]) : bf_lo(z8[u][e >> 1]); y[e] = v[e] * rstd * gg[e] * silu_f(z); }
            u32x4v o; o[0] = cvt_pk_bf16(y[0], y[1]); o[1] = cvt_pk_bf16(y[2], y[3]); o[2] = cvt_pk_bf16(y[4], y[5]); o[3] = cvt_pk_bf16(y[6], y[7]);
            *(u32x4v*)(merged + (size_t)row * 2048 + c0) = o;
        }
    }
}

constexpr int N_PHASES = 25;
__device__ NOINL void phase_gemm1(const Params* gp, int L, L8* smem) {
    PHASE_ENTRY;
    const int odd = L & 1;
    EpiIn E{(bf16_t*)(p.ws + OFF_P1), (bf16_t*)(p.ws + OFF_VT), (float*)(p.ws + OFF_RBUF), odd, smem + 131072};
    run_gemm(smem, (const bf16_t*)(p.ws + OFF_H), (const bf16_t*)(p.ws + OFF_WTIN + (size_t)L * SZ_WTIN1), NROW, odd ? N1P : N1, 2048, E);
    if (L < 3) { const int nun = 36 * (odd ? 25 : 24), spare0 = nun % gdim(); if (spare0 > 0 && bidx() >= spare0) aux_layer(p, L + 1, bidx() - spare0, gdim() - spare0, smem, 2); else if (spare0 == 0) aux_layer(p, L + 1, bidx(), gdim(), smem, 2); }
}
__device__ NOINL void phase_glu(const Params* gp, int L, L8* smem) {
    PHASE_ENTRY;
    EpiGlu E{(const bf16_t*)(p.ws + OFF_GBUF), (const bf16_t*)(p.ws + OFF_P1), (bf16_t*)(p.ws + OFF_MERGED)};
    run_gemm(smem, (const bf16_t*)(p.ws + OFF_GBUF), (const bf16_t*)(p.ws + OFF_WTGLU + (size_t)(L >> 1) * SZ_WTGLU1), NROW, 1024, 1024, E);
}
__device__ NOINL void phase_gemm2(const Params* gp, int L, L8* smem) {
    PHASE_ENTRY;
    float* xbuf = (float*)(p.ws + OFF_XBUF);
    EpiOut E{L == 0 ? p.x : xbuf, L == 0 ? p.ctx : xbuf + (size_t)NLAT * 2048, L == 3 ? p.out : xbuf, xbuf + (size_t)NLAT * 2048, (const float*)(p.ws + OFF_MOD) + (size_t)L * 5 * 6144};
    run_gemm(smem, (const bf16_t*)(p.ws + OFF_MERGED), (const bf16_t*)(p.ws + OFF_WTOUT + (size_t)L * SZ_WTOUT1), L == 3 ? NLAT : NROW, 2048, 2048, E);
    if (L < 3) { const int spare0 = 288 - gdim(); if (spare0 >= 0 && spare0 < gdim() && bidx() >= spare0) aux_layer(p, L + 1, bidx() - spare0, gdim() - spare0, smem, 1); else if (spare0 < 0 || spare0 >= gdim()) aux_layer(p, L + 1, bidx(), gdim(), smem, 1); }
}
#ifndef PROBE_MASK
#define PROBE_MASK 0
#endif
__device__ __forceinline__ void run_phase(const Params* gp, int ph, L8* smem) {
    const int mask = gp->ph_lo;
#define NREP(k) (((mask >> (k)) & 1) + 1)
    if (ph == 0) { for (int r = 0; r < NREP(0); ++r) phase_prologue(gp, 0, smem); return; }
    const int L = (ph - 1) / 6, s = (ph - 1) % 6, odd = L & 1;
    if (s == 0) { for (int r = 0; r < NREP(1); ++r) phase_norm(gp, L, smem); }
    else if (s == 1) { for (int r = 0; r < NREP(2); ++r) phase_gemm1(gp, L, smem); }
    else if (s == 2) { if (odd) { for (int r = 0; r < NREP(3); ++r) phase_gla_pre(gp, L, smem); } else { for (int r = 0; r < NREP(4); ++r) phase_s5(gp, L, smem, r == 0); } }
    else if (s == 3) { if (odd) { for (int r = 0; r < NREP(5); ++r) phase_gla(gp, L, smem, L + 4 * r); } else { for (int r = 0; r < NREP(6); ++r) phase_attn(gp, L, smem, L + 4 * r); } }
    else if (s == 4) { if (odd) { for (int r = 0; r < NREP(7); ++r) phase_gla_finish(gp, L, smem); } else { for (int r = 0; r < NREP(8); ++r) phase_glu(gp, L, smem); } }
    else { const int n = (L == 0 || L == 3) ? NREP(9) : 1; for (int r = 0; r < n; ++r) phase_gemm2(gp, L, smem); }
#undef NREP
}

__global__ void __launch_bounds__(512) hybrid_fwd_megakernel(Params p) {
    extern __shared__ __attribute__((aligned(16))) unsigned char smem_raw[];
    L8* smem = (L8*)smem_raw;
    cg::grid_group grid = cg::this_grid();
    const Params* gp = &p;
    unsigned* bar = (unsigned*)(p.ws + OFF_BAR);
    if (blockIdx.x == 0) for (int i = threadIdx.x; i < XCD_BAR_WORDS; i += 512) __hip_atomic_store(bar + i, 0u, __ATOMIC_RELAXED, __HIP_MEMORY_SCOPE_AGENT);
    if (blockIdx.x == 0) for (int i = threadIdx.x; i < 8 * 8 * 16; i += 512) __hip_atomic_store((unsigned*)(p.ws + OFF_CNT) + i, 0u, __ATOMIC_RELAXED, __HIP_MEMORY_SCOPE_AGENT);
    volatile LAS unsigned* st = (volatile LAS unsigned*)(smem + LDS_BYTES - 16);
    if (threadIdx.x < 4) st[threadIdx.x] = 0u;
    __syncthreads();
    run_phase(gp, 0, smem);
    grid.sync();
    XcdBarrier xb = xcd_barrier_post(bar, st);
    const unsigned xbx = xb.x, stw = (unsigned)(unsigned long long)st;
    for (int ph = 1; ph < p.ph_hi; ++ph) {
        if (ph > 1) { unsigned* b2 = bar; unsigned x2 = xbx; unsigned st2 = stw; asm volatile("" : "+s"(b2), "+s"(x2), "+s"(st2)); xb.bar = b2; xb.x = x2; xb.st = (volatile LAS unsigned*)(unsigned long long)st2; xcd_barrier(xb); }
        run_phase(gp, ph, smem);
    }
#ifdef DBG_A
    xcd_barrier(xb);
    {
        const float* dbg = (const float*)(p.ws + OFF_DBG);
        const float va = dbg[DBG_A], vb = dbg[DBG_B] * 0.01f;
        if (blockIdx.x == 0 && threadIdx.x == 0) p.out[0] = va;
        for (int i = blockIdx.x * 512 + threadIdx.x; i < (1 << 20); i += gridDim.x * 512) p.out[(1 << 20) + i] += vb;
    }
#endif
}

extern "C" void kernel_launch(void* const* d_in, const int* in_sizes, int n_in, void* d_out, int out_size, void* d_ws, size_t ws_size, hipStream_t stream) {
    static int grid_blocks = 0;
    if (grid_blocks == 0) {
        if (n_in != 28 || ws_size < WS_END) { fprintf(stderr, "kernel_launch: expected 28 inputs and >= %zu bytes of workspace; got %d, %zu\n", (size_t)WS_END, n_in, ws_size); grid_blocks = -1; return; }
        int dev = 0, cus = 0, per_cu = 0;
        hipGetDevice(&dev);
        hipDeviceGetAttribute(&cus, hipDeviceAttributeMultiprocessorCount, dev);
        if (hipFuncSetAttribute((const void*)hybrid_fwd_megakernel, hipFuncAttributeMaxDynamicSharedMemorySize, LDS_BYTES) != hipSuccess) { fprintf(stderr, "kernel_launch: hipFuncSetAttribute failed\n"); grid_blocks = -1; return; }
        if (hipOccupancyMaxActiveBlocksPerMultiprocessor(&per_cu, (const void*)hybrid_fwd_megakernel, 512, LDS_BYTES) != hipSuccess || per_cu < 1) { fprintf(stderr, "kernel_launch: occupancy query gave %d\n", per_cu); per_cu = 1; }
        (void)hipGetLastError();
        grid_blocks = cus * per_cu;
    }
    if (grid_blocks < 0) return;
    Params p{};
    const float** ip = (const float**)&p;
    for (int i = 0; i < 28; ++i) ip[i] = (const float*)d_in[i];
    p.out = (float*)d_out; p.ws = (unsigned char*)d_ws; p.ph_lo = PROBE_MASK; p.ph_hi = N_PHASES;
    void* args[] = {&p};
    hipError_t e = hipLaunchCooperativeKernel((const void*)hybrid_fwd_megakernel, dim3(grid_blocks), dim3(512), args, LDS_BYTES, stream);
    if (e != hipSuccess) fprintf(stderr, "cooperative launch failed: %s (grid %d)\n", hipGetErrorString(e), grid_blocks);
}
```

```cpp
#include <hip/hip_runtime.h>
#include <hip/hip_cooperative_groups.h>
#include <cstdio>
namespace cg = cooperative_groups;

__device__ __forceinline__ int tidx() { int t = threadIdx.x; asm volatile("" : "+v"(t)); return t; }
__device__ __forceinline__ int bidx() { int t = blockIdx.x; asm volatile("" : "+s"(t)); return t; }
__device__ __forceinline__ int gdim() { int t = gridDim.x; asm volatile("" : "+s"(t)); return t; }
#define XB_TMO      128
#define XB_XCNT(j)  (256  + 64 * (j))
#define XB_XSUB(j)  (1280 + 64 * (j))
#define XB_XGEN(j)  (2304 + 64 * (j))
#define XB_TOP      3328
#define XB_TOPGEN   3392
#define XCD_BAR_WORDS 3456
#define XB_SPIN_CAP (1u << 18)
#define LAS __attribute__((address_space(3)))

__device__ __forceinline__ unsigned xb_ld(unsigned* p)              { return __hip_atomic_load(p, __ATOMIC_RELAXED, __HIP_MEMORY_SCOPE_AGENT); }
__device__ __forceinline__ unsigned xb_add(unsigned* p, unsigned v) { return __hip_atomic_fetch_add(p, v, __ATOMIC_RELAXED, __HIP_MEMORY_SCOPE_AGENT); }
__device__ __forceinline__ unsigned xb_xcc_id() { return (unsigned)__builtin_amdgcn_s_getreg((3 << 11) | 20) & 0xFu; }
#define XB_SPIN(cond, bar) do { unsigned _sp = 0; while (cond) { __builtin_amdgcn_s_sleep(1); \
    if ((++_sp & 255u) == 0u) { if (xb_ld(&(bar)[XB_TMO])) break; if (_sp > XB_SPIN_CAP) { atomicAdd(&(bar)[XB_TMO], 1u); break; } } } } while (0)

struct XcdBarrier {
    unsigned* bar; unsigned x;
    volatile LAS unsigned* st;
};

__device__ __forceinline__ XcdBarrier xcd_barrier_post(unsigned* bar, volatile LAS unsigned* st) {
    XcdBarrier b; b.bar = bar; b.x = xb_xcc_id(); b.st = st;
    if (tidx() == 0) (void)xb_add(&bar[XB_XCNT(b.x)], 1u);
    return b;
}
__device__ __forceinline__ void xcd_barrier_complete(unsigned* bar, unsigned x, unsigned& nloc, unsigned& nx) {
    const unsigned G = gridDim.x;
    unsigned sum, cnt, mine, sp = 0u;
    for (;;) {
        sum = 0u; cnt = 0u; mine = 0u;
#pragma unroll
        for (unsigned j = 0; j < 16; ++j) { const unsigned c = xb_ld(&bar[XB_XCNT(j)]); sum += c; cnt += (c > 0u) ? 1u : 0u; mine = (j == x) ? c : mine; }
        if (sum == G) break;
        __builtin_amdgcn_s_sleep(1);
        if ((++sp & 255u) == 0u) { if (xb_ld(&bar[XB_TMO])) break; if (sp > XB_SPIN_CAP) { atomicAdd(&bar[XB_TMO], 1u); break; } }
    }
    nloc = mine > 0u ? mine : 1u; nx = cnt > 0u ? cnt : 1u;
}

__device__ __forceinline__ void xcd_barrier(const XcdBarrier& b) {
    asm volatile("s_waitcnt vmcnt(0)" ::: "memory");
    __syncthreads();
    if (tidx() == 0) {
        unsigned* bar = b.bar;
        __builtin_amdgcn_s_waitcnt(0);
        unsigned nloc = b.st[0], nx = b.st[1];
        if (nloc == 0u) { xcd_barrier_complete(bar, b.x, nloc, nx); b.st[0] = nloc; b.st[1] = nx; }
        const unsigned old = xb_add(&bar[XB_XSUB(b.x)], 1u);
        const unsigned gen = old / nloc;
        if (old + 1u == (gen + 1u) * nloc) {
            __builtin_amdgcn_fence(__ATOMIC_RELEASE, "agent");
            asm volatile("s_waitcnt vmcnt(0)" ::: "memory");
            const unsigned og = xb_add(&bar[XB_TOP], 1u);
            const unsigned tg = og / nx;
            if (og + 1u == (tg + 1u) * nx) xb_add(&bar[XB_TOPGEN], 1u);
            else XB_SPIN(xb_ld(&bar[XB_TOPGEN]) == tg, bar);
            __builtin_amdgcn_fence(__ATOMIC_ACQUIRE, "agent");
            xb_add(&bar[XB_XGEN(b.x)], 1u);
            asm volatile("s_waitcnt vmcnt(0)" ::: "memory");
        } else {
            XB_SPIN(xb_ld(&bar[XB_XGEN(b.x)]) == gen, bar);
            __builtin_amdgcn_fence(__ATOMIC_ACQUIRE, "agent");
            asm volatile("s_waitcnt vmcnt(0)" ::: "memory");
        }
    }
    __syncthreads();
}

namespace pg8 {
#define PG8_LAS __attribute__((address_space(3)))
typedef unsigned short bf16_t;
typedef short bf16x8 __attribute__((ext_vector_type(8)));
typedef float f32x4 __attribute__((ext_vector_type(4)));
typedef unsigned u32x4 __attribute__((ext_vector_type(4)));
constexpr int BM = 256, BK = 64, HALF = 128, HTB = HALF * BK * 2  , STAGE_BYTES = 8 * HTB, NXCD = 8, WGM = 8;

__host__ __device__ __forceinline__ int lds_byte(int r, int c) { const int st = (r >> 4) * 2 + (c >> 5), rr = r & 15, cc = c & 31, ob = rr * 64 + cc * 2; return st * 1024 + (ob ^ (((ob >> 9) & 1) << 5)); }
__host__ __device__ __forceinline__ void stage_rc(int b, int& R, int& C) { const int st = b / 1024, sb = b % 1024, swz = sb ^ (((sb >> 9) & 1) << 5); R = (st >> 1) * 16 + swz / 64; C = (st & 1) * 32 + (swz % 64) / 2; }
__host__ __device__ __forceinline__ int perm32(int rho) { const int n = rho >> 4, i = rho & 15; return 8 * (i >> 2) + 4 * n + (i & 3); }

struct Unit { int pm, pn; };
struct Gemm { const bf16_t* A; const bf16_t* Bt; int M, N, K; };

struct StaticOrder {
    int nM, nN, nwg, G, c;
    __host__ __device__ void init(int M, int N, int G_, int c_) { nM = M / BM; nN = N / BM; nwg = nM * nN; G = G_; c = c_; }
    __host__ __device__ bool next(int i, Unit& u) const {
        const long L = (long)i * G + c; if (L >= nwg) return false;
        int wgid = (int)L; { const int q = nwg / NXCD, r = nwg % NXCD, xcd = wgid % NXCD, off = wgid / NXCD; wgid = (xcd < r ? xcd * (q + 1) : r * (q + 1) + (xcd - r) * q) + off; }
        const int nig = WGM * nN, gid = wgid / nig, fm = gid * WGM, gsz = (nM - fm) < WGM ? (nM - fm) : WGM;
        u.pm = fm + ((wgid % nig) % gsz); u.pn = (wgid % nig) / gsz; return true;
    }
    __device__ __forceinline__ void a_ready(const Unit&) const {}
    __device__ __forceinline__ void done(const Unit&) const {}
};
__device__ __forceinline__ unsigned cvt_pk_bf16(float lo, float hi) { unsigned r; asm volatile("v_cvt_pk_bf16_f32 %0, %1, %2" : "=v"(r) : "v"(lo), "v"(hi)); return r; }
template <class Epi, class Sched, bool STAMP = false>
__device__ __forceinline__ void gemm_phase(PG8_LAS unsigned char* lds, const Gemm g, const Sched& S, const Epi& E, unsigned long long* stamps) {
    const int tid = tidx(), wid = __builtin_amdgcn_readfirstlane(tid >> 6), lane = tid & 63, wr = wid >> 2, wc = wid & 3, fr = lane & 15, fq = lane >> 4;
    const int K = g.K, nt = K / BK;
    int ts_lo = 0, ts_hi = 0, nts = 0; const unsigned long long rt_entry = STAMP ? (unsigned long long)wall_clock64() : 0ull;
#define PG8_STAMP() do { if (STAMP && wid == 0 && nts < 64) { const unsigned long long _c = (unsigned long long)clock64(); \
        ts_lo = (lane == nts) ? (int)(unsigned)_c : ts_lo; ts_hi = (lane == nts) ? (int)(unsigned)(_c >> 32) : ts_hi; ++nts; } } while (0)
    PG8_STAMP();
    unsigned voffA[2], voffB[2];
#pragma unroll
    for (int i = 0; i < 2; ++i) { int R, C; stage_rc(tid * 16 + i * 8192, R, C); const int Rb = Epi::PERM ? ((R & ~31) + perm32(R & 31)) : R;
        voffA[i] = (unsigned)(R * K + C) * 2u; voffB[i] = (unsigned)(Rb * K + C) * 2u; }
    const size_t kstep = (size_t)(BK * 2);
    const size_t hstep = (size_t)HALF * K * 2;
    const size_t tstep = 2 * hstep;
    const unsigned ldsw = (unsigned)wid * 1024u;
    const int aoff = lds_byte(wr * 64 + fr, fq * 8), boff = lds_byte(wc * 32 + fr, fq * 8);
#define PG8_SA(b, h) (((b) * 2 + (h)) * HTB)
#define PG8_SB(b, h) ((4 + (b) * 2 + (h)) * HTB)
#define PG8_STAGE(bufoff, gbase, voff) do { _Pragma("unroll") for (int _i = 0; _i < 2; ++_i) \
        __builtin_amdgcn_global_load_lds((const unsigned*)((const char*)(gbase) + (voff)[_i]), (PG8_LAS unsigned*)(lds + (bufoff) + ldsw + _i * 8192), 16, 0, 0); } while (0)
#define PG8_LDA(dst, b, h) do { _Pragma("unroll") for (int m = 0; m < 4; ++m) _Pragma("unroll") for (int k = 0; k < 2; ++k) dst[m][k] = *(const PG8_LAS bf16x8*)(lds + PG8_SA(b, h) + aoff + m * 2048 + k * 1024); } while (0)
#define PG8_LDB(dst, b, h) do { _Pragma("unroll") for (int n = 0; n < 2; ++n) _Pragma("unroll") for (int k = 0; k < 2; ++k) dst[n][k] = *(const PG8_LAS bf16x8*)(lds + PG8_SB(b, h) + boff + n * 2048 + k * 1024); } while (0)
#define PG8_MMA(ai, bj, At, Bt) do { __builtin_amdgcn_s_setprio(1); _Pragma("unroll") for (int m = 0; m < 4; ++m) _Pragma("unroll") for (int n = 0; n < 2; ++n) _Pragma("unroll") for (int k = 0; k < 2; ++k) \
        acc[ai][bj][m][n] = __builtin_amdgcn_mfma_f32_16x16x32_bf16(Bt[n][k], At[m][k], acc[ai][bj][m][n], 0, 0, 0); __builtin_amdgcn_s_setprio(0); } while (0)
#define PG8_WAIT_V(n) asm volatile("s_waitcnt vmcnt(" #n ")" ::: "memory")
#define PG8_WAIT_L(n) asm volatile("s_waitcnt lgkmcnt(" #n ")" ::: "memory")
#define PG8_BAR __builtin_amdgcn_s_barrier()
#define PG8_SCHED __builtin_amdgcn_sched_barrier(0)
    Unit cur, nxt; int ui = 0;
    if (!S.next(0, cur)) return;
    f32x4 acc[2][2][4][2];
#pragma unroll
    for (int a = 0; a < 2; ++a)
#pragma unroll
        for (int b = 0; b < 2; ++b)
#pragma unroll
            for (int m = 0; m < 4; ++m)
#pragma unroll
                for (int n = 0; n < 2; ++n) acc[a][b][m][n] = (f32x4){0.f, 0.f, 0.f, 0.f};
    bf16x8 At[4][2], B0[2][2], B1[2][2];
    const char* cA = (const char*)g.A + (size_t)cur.pm * tstep; const char* cB = (const char*)g.Bt + (size_t)cur.pn * tstep;
    S.a_ready(cur);
    PG8_STAGE(PG8_SB(0, 0), cB, voffB); PG8_STAGE(PG8_SA(0, 0), cA, voffA); PG8_STAGE(PG8_SB(0, 1), cB + hstep, voffB); PG8_STAGE(PG8_SA(0, 1), cA + hstep, voffA);
    if (wr == 1) PG8_BAR;
    PG8_WAIT_V(4); PG8_BAR;
    PG8_STAGE(PG8_SB(1, 0), cB + kstep, voffB); PG8_STAGE(PG8_SA(1, 0), cA + kstep, voffA); PG8_STAGE(PG8_SB(1, 1), cB + hstep + kstep, voffB);
    PG8_WAIT_V(6); PG8_BAR;
    PG8_STAMP();
    for (;;) {
        const bool has_next = S.next(ui + 1, nxt);
        const char* nA = has_next ? (const char*)g.A + (size_t)nxt.pm * tstep : cA; const char* nB = has_next ? (const char*)g.Bt + (size_t)nxt.pn * tstep : cB;
        for (int t = 0; t < nt; t += 2) {
            const bool last = (t == nt - 2);
            const char* a1 = cA + (size_t)(t + 1) * kstep;
            const char* a2 = last ? nA : cA + (size_t)(t + 2) * kstep; const char* b2 = last ? nB : cB + (size_t)(t + 2) * kstep;
            const char* a3 = a2 + kstep; const char* b3 = b2 + kstep;
            if (last && has_next) S.a_ready(nxt);
            PG8_LDB(B0, 0, 0); PG8_SCHED; PG8_LDA(At, 0, 0); PG8_STAGE(PG8_SA(1, 1), a1 + hstep, voffA);
            PG8_WAIT_L(8); PG8_BAR; PG8_WAIT_L(0); PG8_MMA(0, 0, At, B0); PG8_BAR; PG8_SCHED;
            PG8_LDB(B1, 0, 1); PG8_STAGE(PG8_SB(0, 0), b2, voffB);
            PG8_BAR; PG8_WAIT_L(0); PG8_MMA(0, 1, At, B1); PG8_BAR;
            PG8_LDA(At, 0, 1); PG8_STAGE(PG8_SA(0, 0), a2, voffA);
            PG8_BAR; PG8_WAIT_L(0); PG8_MMA(1, 0, At, B0); PG8_BAR; PG8_SCHED;
            PG8_STAGE(PG8_SB(0, 1), b2 + hstep, voffB);
            PG8_WAIT_V(6); PG8_BAR; PG8_MMA(1, 1, At, B1); PG8_BAR;
            PG8_LDB(B0, 1, 0); PG8_SCHED; PG8_LDA(At, 1, 0); PG8_STAGE(PG8_SA(0, 1), a2 + hstep, voffA);
            PG8_WAIT_L(8); PG8_BAR; PG8_WAIT_L(0); PG8_MMA(0, 0, At, B0); PG8_BAR; PG8_SCHED;
            PG8_LDB(B1, 1, 1); PG8_STAGE(PG8_SB(1, 0), b3, voffB);
            PG8_BAR; PG8_WAIT_L(0); PG8_MMA(0, 1, At, B1); PG8_BAR;
            PG8_LDA(At, 1, 1); PG8_STAGE(PG8_SA(1, 0), a3, voffA);
            PG8_BAR; PG8_WAIT_L(0); PG8_MMA(1, 0, At, B0); PG8_BAR; PG8_SCHED;
            PG8_STAGE(PG8_SB(1, 1), b3 + hstep, voffB);
            PG8_WAIT_V(6); PG8_BAR; PG8_MMA(1, 1, At, B1); PG8_BAR;
        }
        PG8_STAMP();
        if constexpr (!Epi::AFTER_DRAIN) { E(acc, cur, wr, wc, fr, fq); S.done(cur); }
        PG8_STAMP();
        if (!has_next) break;
#pragma unroll
        for (int a = 0; a < 2; ++a)
#pragma unroll
            for (int b = 0; b < 2; ++b)
#pragma unroll
                for (int m = 0; m < 4; ++m)
#pragma unroll
                    for (int n = 0; n < 2; ++n) acc[a][b][m][n] = (f32x4){0.f, 0.f, 0.f, 0.f};
        cur = nxt; cA = nA; cB = nB; ++ui;
    }
    PG8_WAIT_V(0);
    if (wr == 0) PG8_BAR;
    PG8_BAR;
    if constexpr (Epi::AFTER_DRAIN) { E.fused(acc, cur, wr, wc, fr, fq, lds, wid, lane); S.done(cur); }
    PG8_STAMP();
    if (STAMP && wid == 0) { stamps[lane] = lane < nts ? (((unsigned long long)(unsigned)ts_hi << 32) | (unsigned)ts_lo) : 0ull;
        if (lane == 62) stamps[62] = rt_entry; if (lane == 63) stamps[63] = (unsigned long long)wall_clock64(); }
#undef PG8_STAMP
#undef PG8_SA
#undef PG8_SB
#undef PG8_STAGE
#undef PG8_LDA
#undef PG8_LDB
#undef PG8_MMA
#undef PG8_WAIT_V
#undef PG8_WAIT_L
#undef PG8_BAR
#undef PG8_SCHED
}
}

using pg8::bf16_t; using pg8::bf16x8; using pg8::f32x4; using pg8::cvt_pk_bf16;
typedef float f32x16 __attribute__((ext_vector_type(16)));
typedef short bf16x4 __attribute__((ext_vector_type(4)));
typedef unsigned u32x2 __attribute__((ext_vector_type(2)));
typedef float f32x2v __attribute__((ext_vector_type(2)));
typedef unsigned u32x4v __attribute__((ext_vector_type(4)));

constexpr int DM = 2048, NLAT = 8192, NROW = 9216, N1 = 6144, N1P = 6400;
constexpr size_t SZ_WTIN1 = (size_t)N1P * DM * 2, SZ_WTOUT1 = (size_t)DM * DM * 2, SZ_WTGLU1 = (size_t)1024 * 1024 * 2;
constexpr size_t OFF_WTIN = 0;
constexpr size_t OFF_WTOUT = OFF_WTIN + 4 * SZ_WTIN1;
constexpr size_t OFF_WTGLU = OFF_WTOUT + 4 * SZ_WTOUT1;
constexpr size_t OFF_MOD = OFF_WTGLU + 2 * SZ_WTGLU1;
constexpr size_t OFF_ROPE = OFF_MOD + (size_t)4 * 5 * 6144 * 4;
constexpr size_t OFF_H = OFF_ROPE + 8192;
constexpr size_t OFF_P1 = OFF_H + (size_t)NROW * DM * 2;
constexpr size_t OFF_XBUF = OFF_P1 + (size_t)NROW * N1 * 2;
constexpr size_t OFF_MERGED = OFF_XBUF + (size_t)NROW * DM * 4;
constexpr size_t OFF_VT = OFF_MERGED + (size_t)NROW * DM * 2;
constexpr size_t OFF_RBUF = OFF_VT + (size_t)NROW * DM * 2;
constexpr size_t OFF_DEC = OFF_RBUF + (size_t)NROW * 32 * 4;
constexpr size_t OFF_U = OFF_DEC + (size_t)2 * 144 * 1024 * 4;
constexpr size_t OFF_YBUF = OFF_U;
constexpr size_t OFF_GBUF = OFF_YBUF + (size_t)2 * NROW * 1024 * 4;
constexpr size_t OFF_QD = OFF_U;
constexpr size_t OFF_KD = OFF_QD + (size_t)2 * NROW * 1024 * 2;
constexpr size_t OFF_KET = OFF_KD + (size_t)2 * NROW * 1024 * 2;
constexpr size_t OFF_OBUF = OFF_KET + (size_t)2 * NROW * 1024 * 2;
constexpr size_t OFF_PARAMS = OFF_OBUF + (size_t)2 * NROW * DM * 4;
constexpr size_t OFF_BAR = OFF_PARAMS + 1024 * 256;
constexpr size_t OFF_CNT = OFF_BAR + 16384;
constexpr size_t OFF_DBG = OFF_CNT + 8 * 8 * 64;
constexpr size_t WS_END = OFF_DBG + 4096;
constexpr int LDS_BYTES = 160 * 1024;

struct Params {
    const float *x, *c, *ctx, *c_ctx, *ada_w, *ada_b, *norm_g, *ev_w_in, *ev_w_out;
    const float *s5_a_re, *s5_a_im, *s5_log_dt, *s5_b_re, *s5_b_im, *s5_c_re, *s5_c_im, *s5_d, *s5_w_glu;
    const float *da_qn_g, *da_kn_g, *da_lam, *da_subln_g, *od_w_in, *od_w_out, *gla_wa1, *gla_wa2, *gla_ba, *gla_norm_g;
    float* out; unsigned char* ws;
    int ph_lo, ph_hi;
};

__device__ __forceinline__ float bf_lo(unsigned u) { return __uint_as_float(u << 16); }
__device__ __forceinline__ float bf_hi(unsigned u) { return __uint_as_float(u & 0xffff0000u); }
__device__ __forceinline__ float bf2f(bf16_t b) { return __uint_as_float(((unsigned)b) << 16); }
__device__ __forceinline__ bf16_t f2bf(float f) { return (bf16_t)(cvt_pk_bf16(f, 0.f) & 0xffffu); }
__device__ __forceinline__ f32x16 mfma32(bf16x8 a, bf16x8 b, f32x16 c) { return __builtin_amdgcn_mfma_f32_32x32x16_bf16(a, b, c, 0, 0, 0); }
__device__ __forceinline__ f32x4 mfma16(bf16x8 a, bf16x8 b, f32x4 c) { return __builtin_amdgcn_mfma_f32_16x16x32_bf16(a, b, c, 0, 0, 0); }
__device__ __forceinline__ float shfl_from(float v, int srclane) { return __int_as_float(__builtin_amdgcn_ds_bpermute(srclane << 2, __float_as_int(v))); }
__device__ __forceinline__ float shfl_x(float v, int mask, int lane) { return shfl_from(v, lane ^ mask); }
__device__ __forceinline__ float wave_sum(float v, int lane) {
#pragma unroll
    for (int o = 32; o > 0; o >>= 1) v += shfl_x(v, o, lane);
    return v;
}
__device__ __forceinline__ bf16x8 pack8(float a0, float a1, float a2, float a3, float a4, float a5, float a6, float a7) {
    u32x4v u; u[0] = cvt_pk_bf16(a0, a1); u[1] = cvt_pk_bf16(a2, a3); u[2] = cvt_pk_bf16(a4, a5); u[3] = cvt_pk_bf16(a6, a7);
    return __builtin_bit_cast(bf16x8, u);
}
__device__ __forceinline__ float silu_f(float v) { return v * __builtin_amdgcn_rcpf(1.f + __expf(-v)); }
__device__ __forceinline__ float sigmoid_f(float v) { return __builtin_amdgcn_rcpf(1.f + __expf(-v)); }
__device__ __forceinline__ void wave_lds_sync() { asm volatile("s_waitcnt lgkmcnt(0)" ::: "memory"); __builtin_amdgcn_wave_barrier(); }
typedef __attribute__((address_space(3))) unsigned char L8;
typedef __attribute__((address_space(3))) float LF;
typedef __attribute__((address_space(3))) unsigned short LB;
#define LV(T, ptr) (*(__attribute__((address_space(3))) T*)(ptr))
#define NOINL __forceinline__

__device__ __forceinline__ unsigned long long uni64(unsigned long long v) {
    const unsigned lo = (unsigned)__builtin_amdgcn_readfirstlane((int)(unsigned)v), hi = (unsigned)__builtin_amdgcn_readfirstlane((int)(unsigned)(v >> 32));
    return ((unsigned long long)hi << 32) | lo;
}
#define LAUNDER_S(x) asm volatile("" : "+s"(x))
#define LAUNDER_G(field, T) do { unsigned long long v_ = (unsigned long long)(field); asm volatile("" : "+s"(v_)); field = (T*)(__attribute__((address_space(1))) T*)v_; } while (0)
__device__ __forceinline__ Params load_params(const Params* gp) {
    Params p = *gp;
    LAUNDER_G(p.x, const float); LAUNDER_G(p.c, const float); LAUNDER_G(p.ctx, const float); LAUNDER_G(p.c_ctx, const float); LAUNDER_G(p.ada_w, const float); LAUNDER_G(p.ada_b, const float);
    LAUNDER_G(p.norm_g, const float); LAUNDER_G(p.ev_w_in, const float); LAUNDER_G(p.ev_w_out, const float);
    LAUNDER_G(p.s5_a_re, const float); LAUNDER_G(p.s5_a_im, const float); LAUNDER_G(p.s5_log_dt, const float); LAUNDER_G(p.s5_b_re, const float); LAUNDER_G(p.s5_b_im, const float);
    LAUNDER_G(p.s5_c_re, const float); LAUNDER_G(p.s5_c_im, const float); LAUNDER_G(p.s5_d, const float); LAUNDER_G(p.s5_w_glu, const float);
    LAUNDER_G(p.da_qn_g, const float); LAUNDER_G(p.da_kn_g, const float); LAUNDER_G(p.da_lam, const float); LAUNDER_G(p.da_subln_g, const float); LAUNDER_G(p.od_w_in, const float); LAUNDER_G(p.od_w_out, const float);
    LAUNDER_G(p.gla_wa1, const float); LAUNDER_G(p.gla_wa2, const float); LAUNDER_G(p.gla_ba, const float); LAUNDER_G(p.gla_norm_g, const float);
    LAUNDER_G(p.out, float); LAUNDER_G(p.ws, unsigned char);
    return p;
}
__device__ __forceinline__ L8* uni_lds(L8* q) { return (L8*)(unsigned long long)(unsigned)__builtin_amdgcn_readfirstlane((int)(unsigned)(unsigned long long)q); }
#define PHASE_ENTRY const Params p = load_params(gp); LAUNDER_S(L)

__device__ __forceinline__ void aux_layer(const Params& p, int Lw, int part, int nparts, L8* smem, int what  ) {
    const int tid = tidx();
    LF* lds = (LF*)smem;
    const int oddw = Lw & 1, jw = Lw >> 1;
    const int ntile = (what & 1) ? 3072 + 1024 + (oddw ? 0 : 256) : 0;
    for (int t = part; t < ntile; t += nparts) {
        const float* W; bf16_t* Wt; int K, N, tk, tn;
        if (t < 3072) { tk = t / 96; tn = t % 96; K = 2048; N = 6144;
            W = (oddw ? p.od_w_in : p.ev_w_in) + (size_t)jw * 2048 * 6144; Wt = (bf16_t*)(p.ws + OFF_WTIN + (size_t)Lw * SZ_WTIN1); }
        else if (t < 4096) { const int t2 = t - 3072; tk = t2 / 32; tn = t2 % 32; K = 2048; N = 2048;
            W = (oddw ? p.od_w_out : p.ev_w_out) + (size_t)jw * 2048 * 2048; Wt = (bf16_t*)(p.ws + OFF_WTOUT + (size_t)Lw * SZ_WTOUT1); }
        else { const int t3 = t - 4096; tk = t3 / 16; tn = t3 % 16; K = 1024; N = 1024;
            W = p.s5_w_glu + (size_t)jw * 1024 * 1024; Wt = (bf16_t*)(p.ws + OFF_WTGLU + (size_t)jw * SZ_WTGLU1); }
        {
            const int r = tid >> 3, c8 = (tid & 7) * 8;
            const float* src = W + (size_t)(tk * 64 + r) * N + tn * 64 + c8;
            const float4 a = *(const float4*)src, b = *(const float4*)(src + 4);
            LF* d = lds + r * 65 + c8;
            d[0] = a.x; d[1] = a.y; d[2] = a.z; d[3] = a.w; d[4] = b.x; d[5] = b.y; d[6] = b.z; d[7] = b.w;
        }
        __syncthreads();
        {
            const int n = tid >> 3, k8 = (tid & 7) * 8;
            const LF* s = lds + k8 * 65 + n;
            u32x4v o; o[0] = cvt_pk_bf16(s[0], s[65]); o[1] = cvt_pk_bf16(s[130], s[195]); o[2] = cvt_pk_bf16(s[260], s[325]); o[3] = cvt_pk_bf16(s[390], s[455]);
            *(u32x4v*)(Wt + (size_t)(tn * 64 + n) * K + tk * 64 + k8) = o;
        }
        __syncthreads();
    }
    if (oddw && (what & 1)) {
        bf16_t* Wt = (bf16_t*)(p.ws + OFF_WTIN + (size_t)Lw * SZ_WTIN1);
        for (int idx = part * 512 + tid; idx < 256 * 2048; idx += nparts * 512) {
            const int rr = idx / 2048, k = idx % 2048;
            float v = 0.f;
            if (rr < 32) { const int d = rr >> 4, n = rr & 15; v = p.gla_wa1[((size_t)(jw * 2 + d) * 2048 + k) * 16 + n]; }
            Wt[(size_t)(6144 + rr) * 2048 + k] = f2bf(v);
        }
    }
    if (!(what & 2)) return;
    __syncthreads();
    for (int i = tid; i < 5 * 2048; i += 512) { const int r = i >> 11, k = i & 2047; const float v = r < 4 ? p.c[r * 2048 + k] : p.c_ctx[k]; lds[i] = v / (1.f + expf(-v)); }
    __syncthreads();
    LF* red = lds + 5 * 2048;
    float* mod = (float*)(p.ws + OFF_MOD);
    for (int s = part; s < 96; s += nparts) {
        const int n0 = s * 64, col = (tid & 31) * 2, ks = tid >> 5;
        const float* w = p.ada_w + (size_t)Lw * 2048 * 6144 + n0 + col;
        float a[5][2];
#pragma unroll
        for (int r = 0; r < 5; ++r) { a[r][0] = 0.f; a[r][1] = 0.f; }
#pragma unroll 1
        for (int k0 = ks; k0 < 2048; k0 += 256) {
            f32x2v wv[16];
#pragma unroll
            for (int u = 0; u < 16; ++u) wv[u] = *(const f32x2v*)(w + (size_t)(k0 + 16 * u) * 6144);
#pragma unroll
            for (int u = 0; u < 16; ++u) {
                const int k = k0 + 16 * u;
#pragma unroll
                for (int r = 0; r < 5; ++r) { const float sv = lds[r * 2048 + k]; a[r][0] += sv * wv[u][0]; a[r][1] += sv * wv[u][1]; }
            }
        }
#pragma unroll
        for (int r = 0; r < 5; ++r) { red[(ks * 5 + r) * 64 + col] = a[r][0]; red[(ks * 5 + r) * 64 + col + 1] = a[r][1]; }
        __syncthreads();
        if (tid < 320) {
            const int r = tid >> 6, c2 = tid & 63; float sum = 0.f;
#pragma unroll
            for (int q = 0; q < 16; ++q) sum += red[(q * 5 + r) * 64 + c2];
            mod[(size_t)(Lw * 5 + r) * 6144 + n0 + c2] = sum + p.ada_b[Lw * 6144 + n0 + c2];
        }
        __syncthreads();
    }
}

__device__ NOINL void phase_prologue(const Params* gp, int L, L8* smem) {
    PHASE_ENTRY;
    const int tid = tidx();
    if (bidx() == 0) {
        float* rope = (float*)(p.ws + OFF_ROPE);
        for (int idx = tid; idx < 1024; idx += 512) {
            const int pos = idx >> 4, i = idx & 15;
            const float inv = powf(10000.0f, -(float)i / 16.0f);
            const float ang = (float)pos * inv;
            rope[idx * 2] = cosf(ang); rope[idx * 2 + 1] = sinf(ang);
        }
    }
    aux_layer(p, 0, bidx(), gdim(), smem, 3);
}

__device__ NOINL void phase_norm(const Params* gp, int L, L8* smem) {
    PHASE_ENTRY;
    const int wave = tidx() >> 6, lane = tidx() & 63;
    const float* g = p.norm_g + L * 2048;
    const float* xbuf = (const float*)(p.ws + OFF_XBUF);
    bf16_t* h = (bf16_t*)(p.ws + OFF_H);
    const float* mod = (const float*)(p.ws + OFF_MOD);
    const int step = gdim() * 8;
    int row = bidx() * 8 + wave;
#define NORM_XPTR(r_) ((L == 0) ? ((r_) < NLAT ? p.x + (size_t)(r_) * 2048 : p.ctx + (size_t)((r_) - NLAT) * 2048) : xbuf + (size_t)(r_) * 2048)
    float4 vn[8];
    if (row < NROW) { const float* xr = NORM_XPTR(row);
#pragma unroll
        for (int i = 0; i < 8; ++i) vn[i] = *(const float4*)(xr + i * 256 + lane * 4); }
    for (; row < NROW; row += step) {
        const int mrow = row < NLAT ? (row >> 11) : 4;
        const float* md = mod + (size_t)(L * 5 + mrow) * 6144;
        float4 v[8], gg[8], sh[8], sc[8];
#pragma unroll
        for (int i = 0; i < 8; ++i) { const int c = i * 256 + lane * 4; v[i] = vn[i]; gg[i] = *(const float4*)(g + c); sh[i] = *(const float4*)(md + c); sc[i] = *(const float4*)(md + 2048 + c); }
        { const int nr = (row + step < NROW) ? row + step : row; const float* xr = NORM_XPTR(nr);
#pragma unroll
            for (int i = 0; i < 8; ++i) vn[i] = *(const float4*)(xr + i * 256 + lane * 4); }
        float ss = 0.f;
#pragma unroll
        for (int i = 0; i < 8; ++i) ss += v[i].x * v[i].x + v[i].y * v[i].y + v[i].z * v[i].z + v[i].w * v[i].w;
        ss = wave_sum(ss, lane);
        const float rstd = rsqrtf(ss * (1.f / 2048.f) + 1e-6f);
#pragma unroll
        for (int i = 0; i < 8; ++i) {
            const int c = i * 256 + lane * 4;
            const float o0 = (v[i].x * rstd * gg[i].x) * (1.f + sc[i].x) + sh[i].x, o1 = (v[i].y * rstd * gg[i].y) * (1.f + sc[i].y) + sh[i].y;
            const float o2 = (v[i].z * rstd * gg[i].z) * (1.f + sc[i].z) + sh[i].z, o3 = (v[i].w * rstd * gg[i].w) * (1.f + sc[i].w) + sh[i].w;
            u32x2 o; o[0] = cvt_pk_bf16(o0, o1); o[1] = cvt_pk_bf16(o2, o3);
            *(u32x2*)(h + (size_t)row * 2048 + c) = o;
        }
    }
#undef NORM_XPTR
}

struct EpiIn {
    static constexpr bool PERM = true, AFTER_DRAIN = false;
    bf16_t* P1; bf16_t* vT; float* rbuf; int odd; L8* tl;
    __device__ __forceinline__ void operator()(const f32x4 (&acc)[2][2][4][2], const pg8::Unit& u, int wr, int wc, int fr, int fq) const {
        const int row0 = u.pm * 256 + wr * 64 + fr, colt = u.pn * 256;
        const bool isr = colt >= 6144;
        const bool isv = odd ? (colt >= 2048 && colt < 4096) : (colt >= 4096 && colt < 5120);
        if (isr) {
            if (wc == 0) {
#pragma unroll
                for (int ai = 0; ai < 2; ++ai)
#pragma unroll
                    for (int m = 0; m < 4; ++m) { float* rp = rbuf + (size_t)(row0 + ai * 128 + m * 16) * 32 + 8 * fq;
                        *(f32x4*)rp = acc[ai][0][m][0]; *(f32x4*)(rp + 4) = acc[ai][0][m][1]; }
            }
        } else if (isv) {
            const int lane = fq * 16 + fr;
            LB* T = (LB*)(tl + (wr * 4 + wc) * 2304);
            const int cl_r = lane >> 2, rg = lane & 3;
#pragma unroll
            for (int ai = 0; ai < 2; ++ai) {
                const int rbase = u.pm * 256 + ai * 128 + wr * 64;
                size_t gbase; int estride;
                if (odd) { gbase = ((size_t)(rbase >> 6) * 2048) * 64; estride = 64; }
                else { int b, key; if (rbase < NLAT) { b = rbase >> 11; key = 256 + (rbase & 2047); } else { b = (rbase - NLAT) >> 8; key = (rbase - NLAT) & 255; }
                    gbase = (size_t)b * 8 * 128 * 2304 + key; estride = 2304; }
#pragma unroll
                for (int bj = 0; bj < 2; ++bj)
#pragma unroll
                    for (int n = 0; n < 2; ++n) {
                        const int cbase = (colt - (odd ? 2048 : 4096)) + bj * 128 + wc * 32 + 4 * n;
#pragma unroll
                        for (int m = 0; m < 4; ++m)
#pragma unroll
                            for (int e = 0; e < 4; ++e) T[(4 * fq + e) * 72 + 16 * m + fr] = f2bf(acc[ai][bj][m][n][e]);
                        wave_lds_sync();
                        const int cv = cbase + 8 * (cl_r >> 2) + (cl_r & 3);
#pragma unroll
                        for (int h = 0; h < 2; ++h) { const int g = rg + 4 * h;
                            const u32x4v v = LV(const u32x4v, T + cl_r * 72 + 8 * g);
                            *(u32x4v*)(vT + gbase + (size_t)cv * estride + 8 * g) = v; }
                        wave_lds_sync();
                    }
            }
        } else {
#pragma unroll
            for (int ai = 0; ai < 2; ++ai)
#pragma unroll
                for (int m = 0; m < 4; ++m) { bf16_t* rp = P1 + (size_t)(row0 + ai * 128 + m * 16) * N1 + colt + wc * 32 + 8 * fq;
#pragma unroll
                    for (int bj = 0; bj < 2; ++bj) { const f32x4 v0 = acc[ai][bj][m][0], v1 = acc[ai][bj][m][1];
                        u32x4v o; o[0] = cvt_pk_bf16(v0[0], v0[1]); o[1] = cvt_pk_bf16(v0[2], v0[3]); o[2] = cvt_pk_bf16(v1[0], v1[1]); o[3] = cvt_pk_bf16(v1[2], v1[3]);
                        *(u32x4v*)(rp + bj * 128) = o; } }
        }
    }
};
struct EpiGlu {
    static constexpr bool PERM = true, AFTER_DRAIN = false;
    const bf16_t* gbuf; const bf16_t* P1; bf16_t* merged;
    __device__ __forceinline__ void operator()(const f32x4 (&acc)[2][2][4][2], const pg8::Unit& u, int wr, int wc, int fr, int fq) const {
        const int row0 = u.pm * 256 + wr * 64 + fr, col0 = u.pn * 256 + wc * 32 + 8 * fq;
#pragma unroll
        for (int ai = 0; ai < 2; ++ai) {
            u32x4v g8v[4][2], z8v[4][2];
#pragma unroll
            for (int m = 0; m < 4; ++m)
#pragma unroll
                for (int bj = 0; bj < 2; ++bj) { const int row = row0 + ai * 128 + m * 16, col = col0 + bj * 128;
                    g8v[m][bj] = *(const u32x4v*)(gbuf + (size_t)row * 1024 + col); z8v[m][bj] = *(const u32x4v*)(P1 + (size_t)row * N1 + 1024 + col); }
#pragma unroll
            for (int m = 0; m < 4; ++m) { const int row = row0 + ai * 128 + m * 16;
#pragma unroll
                for (int bj = 0; bj < 2; ++bj) { const int col = col0 + bj * 128;
                    const u32x4v g8 = g8v[m][bj], z8 = z8v[m][bj];
                    u32x4v o;
#pragma unroll
                    for (int e = 0; e < 4; ++e) { const float a0 = acc[ai][bj][m][e >> 1][(e & 1) * 2], a1 = acc[ai][bj][m][e >> 1][(e & 1) * 2 + 1];
                        const float r0 = bf_lo(g8[e]) * sigmoid_f(a0) * silu_f(bf_lo(z8[e])), r1 = bf_hi(g8[e]) * sigmoid_f(a1) * silu_f(bf_hi(z8[e]));
                        o[e] = cvt_pk_bf16(r0, r1); }
                    *(u32x4v*)(merged + (size_t)row * 2048 + col) = o; } }
        }
    }
};
struct EpiOut {
    static constexpr bool PERM = false, AFTER_DRAIN = false;
    const float* xin_lat; const float* xin_ctx; float* xout_lat; float* xout_ctx; const float* mod;
    __device__ __forceinline__ void operator()(const f32x4 (&acc)[2][2][4][2], const pg8::Unit& u, int wr, int wc, int fr, int fq) const {
        const int row0 = u.pm * 256 + wr * 64 + fr, col0 = u.pn * 256 + wc * 32 + 4 * fq;
        const int mrow = (u.pm < 32) ? (u.pm >> 3) : 4;
        const float* gp = mod + (size_t)mrow * 6144 + 4096 + col0;
        f32x4 gv[2][2];
#pragma unroll
        for (int bj = 0; bj < 2; ++bj)
#pragma unroll
            for (int n = 0; n < 2; ++n) gv[bj][n] = *(const f32x4*)(gp + bj * 128 + n * 16);
#pragma unroll
        for (int ai = 0; ai < 2; ++ai) {
            f32x4 xv[4][2][2];
#pragma unroll
            for (int m = 0; m < 4; ++m) { const int row = row0 + ai * 128 + m * 16;
                const float* xi = (row < NLAT) ? xin_lat + (size_t)row * 2048 : xin_ctx + (size_t)(row - NLAT) * 2048;
#pragma unroll
                for (int bj = 0; bj < 2; ++bj)
#pragma unroll
                    for (int n = 0; n < 2; ++n) xv[m][bj][n] = *(const f32x4*)(xi + col0 + bj * 128 + n * 16); }
#pragma unroll
            for (int m = 0; m < 4; ++m) { const int row = row0 + ai * 128 + m * 16;
                float* xo = (row < NLAT) ? xout_lat + (size_t)row * 2048 : xout_ctx + (size_t)(row - NLAT) * 2048;
#pragma unroll
                for (int bj = 0; bj < 2; ++bj)
#pragma unroll
                    for (int n = 0; n < 2; ++n) { const int c = col0 + bj * 128 + n * 16;
                        *(f32x4*)(xo + c) = xv[m][bj][n] + gv[bj][n] * acc[ai][bj][m][n]; } }
        }
    }
};

template <class Epi> __device__ __forceinline__ void run_gemm(L8* smem, const bf16_t* A, const bf16_t* Bt, int M, int N, int K, const Epi& E) {
    pg8::Gemm g{A, Bt, M, N, K};
    pg8::StaticOrder S; S.init(M, N, (int)gdim(), (int)bidx());
    pg8::gemm_phase<Epi, pg8::StaticOrder, false>(smem, g, S, E, nullptr);
    __syncthreads();
}

__device__ __forceinline__ void s5_stream(const Params& p, int j, int b, int g, int d, L8* lds) {
    const int lane = tidx() & 63, r = lane & 31, hh = lane >> 5, cn = lane & 15, q = lane >> 4;
    LF* BU = (LF*)lds;
    LB* Hs = (LB*)(lds + 64 * 132 * 4);
    const bf16_t* P1 = (const bf16_t*)(p.ws + OFF_P1);
    float* ybuf = (float*)(p.ws + OFF_YBUF);
    const int pd = (j * 2 + d) * 64 + g;
    const float are = p.s5_a_re[pd * 64 + lane], aim = p.s5_a_im[pd * 64 + lane];
    const float dt = expf(p.s5_log_dt[pd]);
    const float mag = expf(are * dt), ang = aim * dt;
    float sn, cs; sincosf(ang, &sn, &cs);
    const float lbr = mag * cs, lbi = mag * sn;
    const float nr = lbr - 1.f, ni = lbi, den = are * are + aim * aim;
    const float fre = (nr * are + ni * aim) / den, fim = (ni * are - nr * aim) / den;
    bf16x8 Bf[4];
#pragma unroll
    for (int nt = 0; nt < 4; ++nt) {
        const int ps = 32 * (nt >> 1) + r;
        const float fr_ = shfl_from(fre, ps), fi_ = shfl_from(fim, ps);
        const float* bre = p.s5_b_re + ((size_t)pd * 64 + ps) * 16 + 8 * hh;
        const float* bim = p.s5_b_im + ((size_t)pd * 64 + ps) * 16 + 8 * hh;
        const float4 r0 = *(const float4*)bre, r1 = *(const float4*)(bre + 4), i0 = *(const float4*)bim, i1 = *(const float4*)(bim + 4);
        const float ca = fr_, cb = (nt & 1) ? fi_ : -fi_;
        const float4 x0 = (nt & 1) ? i0 : r0, x1 = (nt & 1) ? i1 : r1, y0 = (nt & 1) ? r0 : i0, y1 = (nt & 1) ? r1 : i1;
        Bf[nt] = pack8(ca * x0.x + cb * y0.x, ca * x0.y + cb * y0.y, ca * x0.z + cb * y0.z, ca * x0.w + cb * y0.w,
                       ca * x1.x + cb * y1.x, ca * x1.y + cb * y1.y, ca * x1.z + cb * y1.z, ca * x1.w + cb * y1.w);
    }
    bf16x8 Cf[4];
#pragma unroll
    for (int ks = 0; ks < 4; ++ks) {
        const size_t off = ((size_t)pd * 16 + cn) * 64 + 16 * ks + 4 * q;
        const float4 c0 = *(const float4*)(p.s5_c_re + off), c1 = *(const float4*)(p.s5_c_im + off);
        Cf[ks] = pack8(c0.x, -c1.x, c0.y, -c1.y, c0.z, -c1.z, c0.w, -c1.w);
    }
    f32x2v hh2 = {0.f, 0.f};
    const f32x2v lbrr = {lbr, lbr}, lbii = {-lbi, lbi};
#define S5_ROWBASE(cq_) (((cq_) < 4) ? (NLAT + b * 256 + (d ? 3 - (cq_) : (cq_)) * 64) : (b * 2048 + (d ? 35 - (cq_) : (cq_) - 4) * 64))
    bf16x8 An[2];
    {
        const int rb0 = S5_ROWBASE(0);
#pragma unroll
        for (int mt = 0; mt < 2; ++mt) { const int s = 32 * mt + r, tok = d ? 63 - s : s; An[mt] = *(const bf16x8*)(P1 + (size_t)(rb0 + tok) * N1 + g * 16 + 8 * hh); }
    }
    for (int cq = 0; cq < 36; ++cq) {
        const int rowbase = S5_ROWBASE(cq);
        const bf16x8 A0 = An[0], A1 = An[1];
        if (cq + 1 < 36) {
            const int rbn = S5_ROWBASE(cq + 1);
#pragma unroll
            for (int mt = 0; mt < 2; ++mt) { const int s = 32 * mt + r, tok = d ? 63 - s : s; An[mt] = *(const bf16x8*)(P1 + (size_t)(rbn + tok) * N1 + g * 16 + 8 * hh); }
        }
#pragma unroll
        for (int mt = 0; mt < 2; ++mt) {
#pragma unroll
            for (int pr = 0; pr < 2; ++pr) {
                f32x16 accR, accI;
#pragma unroll
                for (int i = 0; i < 16; ++i) { accR[i] = 0.f; accI[i] = 0.f; }
                accR = mfma32(mt ? A1 : A0, Bf[2 * pr], accR);
                accI = mfma32(mt ? A1 : A0, Bf[2 * pr + 1], accI);
#pragma unroll
                for (int i = 0; i < 16; ++i) LV(f32x2v, BU + (32 * mt + (i & 3) + 8 * (i >> 2) + 4 * hh) * 132 + 2 * (32 * pr + r)) = (f32x2v){accR[i], accI[i]};
            }
        }
        wave_lds_sync();
#pragma unroll 1
        for (int s0 = 0; s0 < 64; s0 += 16) {
            f32x2v bu[16];
#pragma unroll
            for (int k = 0; k < 16; ++k) bu[k] = LV(const f32x2v, BU + (s0 + k) * 132 + 2 * lane);
#pragma unroll
            for (int k = 0; k < 16; ++k) {
                const f32x2v t = lbrr * hh2 + bu[k];
                hh2 = lbii * __builtin_shufflevector(hh2, hh2, 1, 0) + t;
                LV(unsigned, Hs + (s0 + k) * 136 + 2 * lane) = cvt_pk_bf16(hh2[0], hh2[1]);
            }
        }
        wave_lds_sync();
#pragma unroll
        for (int mt = 0; mt < 4; ++mt) {
            f32x4 y = {0.f, 0.f, 0.f, 0.f};
#pragma unroll
            for (int ks = 0; ks < 4; ++ks) { const bf16x8 A = LV(const bf16x8, Hs + (16 * mt + cn) * 136 + 32 * ks + 8 * q); y = mfma16(A, Cf[ks], y); }
#pragma unroll
            for (int i = 0; i < 4; ++i) { const int s = 16 * mt + 4 * q + i, tok = d ? 63 - s : s;
                ybuf[((size_t)d * NROW + rowbase + tok) * 1024 + g * 16 + cn] = y[i]; }
        }
        wave_lds_sync();
    }
#undef S5_ROWBASE
}

__device__ __forceinline__ void qk_norm_rope(const Params& p, int j, int wid, int nw) {
    const int lane = tidx() & 63, part = lane & 3;
    bf16_t* P1 = (bf16_t*)(p.ws + OFF_P1);
    const float* rope = (const float*)(p.ws + OFF_ROPE);
    for (int it = wid; it < NROW * 2; it += nw) {
        const int row = it >> 1, which = it & 1;
        bf16_t* ptr = P1 + (size_t)row * N1 + 2048 + which * 1024 + lane * 16;
        const u32x4v v0 = *(const u32x4v*)ptr, v1 = *(const u32x4v*)(ptr + 8);
        float x[16];
#pragma unroll
        for (int e = 0; e < 4; ++e) { x[2 * e] = bf_lo(v0[e]); x[2 * e + 1] = bf_hi(v0[e]); x[8 + 2 * e] = bf_lo(v1[e]); x[9 + 2 * e] = bf_hi(v1[e]); }
        float ss = 0.f;
#pragma unroll
        for (int i = 0; i < 16; ++i) ss += x[i] * x[i];
        ss += shfl_x(ss, 1, lane); ss += shfl_x(ss, 2, lane);
        const float rstd = rsqrtf(ss * (1.f / 64.f) + 1e-6f);
        const float* gn = (which ? p.da_kn_g : p.da_qn_g) + j * 64 + part * 16;
#pragma unroll
        for (int i = 0; i < 16; ++i) x[i] *= rstd * gn[i];
        if (row < NLAT) {
            const int t = row & 2047, pos = (part < 2) ? (t >> 6) : (t & 63);
            const float* rt = rope + pos * 32;
#pragma unroll
            for (int i = 0; i < 16; ++i) {
                const float px = shfl_x(x[i], 1, lane), cs = rt[2 * i], sn = rt[2 * i + 1];
                x[i] = (part & 1) ? (x[i] * cs + px * sn) : (x[i] * cs - px * sn);
            }
        }
        if (!which) {
#pragma unroll
            for (int i = 0; i < 16; ++i) x[i] *= 0.125f * 1.4426950408889634f;
        }
        u32x4v o0, o1;
#pragma unroll
        for (int e = 0; e < 4; ++e) { o0[e] = cvt_pk_bf16(x[2 * e], x[2 * e + 1]); o1[e] = cvt_pk_bf16(x[8 + 2 * e], x[9 + 2 * e]); }
        *(u32x4v*)ptr = o0; *(u32x4v*)(ptr + 8) = o1;
    }
}

__device__ NOINL void phase_s5(const Params* gp, int L, L8* smem, int do_qk) {
    PHASE_ENTRY;
    const int wave = tidx() >> 6;
    if (wave < 2) {
        for (int item = bidx(); item < 256; item += gdim()) s5_stream(p, L >> 1, item >> 6, item & 63, wave, smem + wave * 51200);
    } else if (do_qk) {
        qk_norm_rope(p, L >> 1, bidx() * 6 + wave - 2, gdim() * 6);
    }
}

__device__ __forceinline__ int claim_item(unsigned* cnt, int inst, int nitems, int& y, int& tried, L8* smem) {
    volatile LAS int* slot = (volatile LAS int*)(smem + LDS_BYTES - 8);
    const int tid = tidx();
    __syncthreads();
    if (tid < 64) {
        int got = -1;
        if (tried < 8) for (;;) {
            const unsigned c = (tid < 8) ? __hip_atomic_load(cnt + (inst * 8 + tid) * 16, __ATOMIC_RELAXED, __HIP_MEMORY_SCOPE_AGENT) : 0xffffffffu;
            const unsigned long long avail = __builtin_amdgcn_ballot_w64(tid < 8 && c < (unsigned)nitems);
            if (avail == 0ull) break;
            int pick = y;
#pragma unroll
            for (int k = 7; k >= 0; --k) { const int g = (y + k) & 7; if ((avail >> g) & 1ull) pick = g; }
            unsigned idx = 0u;
            if (tid == 0) idx = __hip_atomic_fetch_add(cnt + (inst * 8 + pick) * 16, 1u, __ATOMIC_RELAXED, __HIP_MEMORY_SCOPE_AGENT);
            idx = (unsigned)__builtin_amdgcn_readfirstlane((int)idx);
            if (idx < (unsigned)nitems) { got = (int)idx; y = pick; break; }
        }
        if (tid == 0) { slot[0] = got; slot[1] = y; }
    }
    __syncthreads();
    const int got = slot[0]; y = slot[1];
    if (got < 0) tried = 8;
    return got;
}

__device__ __forceinline__ void attn_item(const Params& p, int L, int b, int h, int qb, int isctx, float lam, float lam_init, L8* smem) {
    const int j = L >> 1, tid = tidx(), w = tid >> 6, lane = tid & 63, r = lane & 31, hh = lane >> 5;
    const int m = w >> 2, qs = w & 3;
    const bf16_t* P1 = (const bf16_t*)(p.ws + OFF_P1);
    const bf16_t* vT = (const bf16_t*)(p.ws + OFF_VT);
    bf16_t* merged = (bf16_t*)(p.ws + OFF_MERGED);
    const int qrow0 = isctx ? (NLAT + b * 256 + qb * 128) : (b * 2048 + qb * 128);
    const int myrow = qrow0 + qs * 32 + r;
    bf16x8 Bq[4];
#pragma unroll
    for (int ks = 0; ks < 4; ++ks) Bq[ks] = *(const bf16x8*)(P1 + (size_t)myrow * N1 + 2048 + h * 128 + m * 64 + 16 * ks + 8 * hh);
    f32x16 ot[4];
#pragma unroll
    for (int dt = 0; dt < 4; ++dt)
#pragma unroll
        for (int i = 0; i < 16; ++i) ot[dt][i] = 0.f;
    float mrun = 0.f, lrun = 0.f;
    const int nkt = isctx ? 4 : 36;
    const int krow = tid >> 3, kseg = tid & 7, vrow = tid >> 2, vseg = tid & 3;
    struct TileRegs { u32x4v k0, k1, v0, v1; };
    TileRegs X, Y;
#define ATT_LOAD(R_, kt_) do { const int ktc_ = (kt_) < nkt ? (kt_) : nkt - 1; const int key_ = ktc_ * 64 + krow; const int grow_ = key_ < 256 ? (NLAT + b * 256 + key_) : (b * 2048 + key_ - 256); \
        const bf16_t* ks_ = P1 + (size_t)grow_ * N1 + 3072 + h * 128 + kseg * 16; R_.k0 = *(const u32x4v*)ks_; R_.k1 = *(const u32x4v*)(ks_ + 8); \
        const bf16_t* vs_ = vT + ((size_t)(b * 8 + h) * 128 + vrow) * 2304 + ktc_ * 64 + vseg * 16; R_.v0 = *(const u32x4v*)vs_; R_.v1 = *(const u32x4v*)(vs_ + 8); } while (0)
#define ATT_STORE(R_, buf) do { L8* kb_ = smem + (buf) * 35840 + krow * 272 + kseg * 32; LV(u32x4v, kb_) = R_.k0; LV(u32x4v, kb_ + 16) = R_.k1; \
        L8* vb_ = smem + (buf) * 35840 + 17408 + vrow * 144 + vseg * 32; \
        LV(u32x2, vb_) = (u32x2){R_.v0[0], R_.v0[1]}; LV(u32x2, vb_ + 16) = (u32x2){R_.v0[2], R_.v0[3]}; LV(u32x2, vb_ + 8) = (u32x2){R_.v1[0], R_.v1[1]}; LV(u32x2, vb_ + 24) = (u32x2){R_.v1[2], R_.v1[3]}; } while (0)
    ATT_LOAD(X, 0);
    ATT_STORE(X, 0);
    ATT_LOAD(X, 1);
    __syncthreads();
    bf16x8 Bp[4];
    auto qk_softmax = [&](const L8* Ks, const int kt) __attribute__((always_inline)) {
        f32x16 st[2];
        const float minit = -mrun;
#pragma unroll
        for (int k2 = 0; k2 < 2; ++k2) {
#pragma unroll
            for (int i = 0; i < 16; ++i) st[k2][i] = minit;
#pragma unroll
            for (int ks = 0; ks < 4; ++ks) { const bf16x8 A = LV(const bf16x8, Ks + (32 * k2 + r) * 272 + (m * 64 + 16 * ks + 8 * hh) * 2); st[k2] = mfma32(A, Bq[ks], st[k2]); }
        }
        float mx = st[0][0];
#pragma unroll
        for (int i = 0; i < 16; ++i) { mx = fmaxf(mx, st[0][i]); mx = fmaxf(mx, st[1][i]); }
        mx = fmaxf(mx, shfl_x(mx, 32, lane));
        if (__builtin_amdgcn_ballot_w64(kt == 0 || mx > 8.f) != 0ull) {
            const float delta = (kt == 0) ? mx : fmaxf(mx, 0.f);
            const float alpha = __builtin_amdgcn_exp2f(-delta);
            mrun += delta; lrun *= alpha;
#pragma unroll
            for (int dt = 0; dt < 4; ++dt)
#pragma unroll
                for (int i = 0; i < 16; ++i) ot[dt][i] *= alpha;
#pragma unroll
            for (int k2 = 0; k2 < 2; ++k2)
#pragma unroll
                for (int i = 0; i < 16; ++i) st[k2][i] -= delta;
        }
        float psum = 0.f;
#pragma unroll
        for (int k2 = 0; k2 < 2; ++k2)
#pragma unroll
            for (int i = 0; i < 16; ++i) { const float pv = __builtin_amdgcn_exp2f(st[k2][i]); st[k2][i] = pv; psum += pv; }
        lrun += psum;
#pragma unroll
        for (int k2 = 0; k2 < 2; ++k2)
#pragma unroll
            for (int s = 0; s < 2; ++s)
                Bp[2 * k2 + s] = pack8(st[k2][8 * s], st[k2][8 * s + 1], st[k2][8 * s + 2], st[k2][8 * s + 3], st[k2][8 * s + 4], st[k2][8 * s + 5], st[k2][8 * s + 6], st[k2][8 * s + 7]);
    };
    auto pv_acc = [&](const L8* Vs) __attribute__((always_inline)) {
#pragma unroll
        for (int k2 = 0; k2 < 2; ++k2)
#pragma unroll
            for (int s = 0; s < 2; ++s)
#pragma unroll
                for (int dt = 0; dt < 4; ++dt) {
                    const bf16x8 av = LV(const bf16x8, Vs + (32 * dt + r) * 144 + (2 * k2 + s) * 32 + hh * 16);
                    ot[dt] = mfma32(av, Bp[2 * k2 + s], ot[dt]);
                }
    };
    int cur = 0, prv = 2;
    auto tile_step = [&](TileRegs& Rn, TileRegs& Rl, const int kt) __attribute__((always_inline)) {
        const int nxt = (cur == 2) ? 0 : cur + 1;
        ATT_LOAD(Rl, kt + 2);
        const L8* Ks = smem + cur * 35840;
        if (m == 0) { qk_softmax(Ks, kt); pv_acc(Ks + 17408); }
        else { if (kt > 0) pv_acc(smem + prv * 35840 + 17408); qk_softmax(Ks, kt); }
        ATT_STORE(Rn, nxt);
        __syncthreads();
        prv = cur; cur = nxt;
    };
    for (int kt = 0; kt < nkt; kt += 2) { tile_step(X, Y, kt); tile_step(Y, X, kt + 1); }
    if (m == 1) pv_acc(smem + prv * 35840 + 17408);
    __syncthreads();
#undef ATT_LOAD
#undef ATT_STORE
    const float ltot = lrun + shfl_x(lrun, 32, lane);
    const float inv = 1.f / ltot;
    LF* ex = (LF*)smem;
    if (m == 1) {
#pragma unroll
        for (int dt = 0; dt < 4; ++dt)
#pragma unroll
            for (int i = 0; i < 16; ++i) { const int dv = 32 * dt + (i & 3) + 8 * (i >> 2) + 4 * hh; ex[(qs * 128 + dv) * 32 + r] = ot[dt][i] * inv; }
    }
    __syncthreads();
    if (m == 0) {
        float ssq = 0.f;
#pragma unroll
        for (int dt = 0; dt < 4; ++dt)
#pragma unroll
            for (int i = 0; i < 16; ++i) { const int dv = 32 * dt + (i & 3) + 8 * (i >> 2) + 4 * hh;
                const float o = ot[dt][i] * inv - lam * ex[(qs * 128 + dv) * 32 + r]; ot[dt][i] = o; ssq += o * o; }
        ssq += shfl_x(ssq, 32, lane);
        const float rstd = rsqrtf(ssq * (1.f / 128.f) + 1e-6f) * (1.f - lam_init);
        const float* sg = p.da_subln_g + j * 128;
        f32x4 ggv[4][4]; u32x2 zzv[4][4];
#pragma unroll
        for (int dt = 0; dt < 4; ++dt)
#pragma unroll
            for (int g4 = 0; g4 < 4; ++g4) { const int dv = 32 * dt + 8 * g4 + 4 * hh; ggv[dt][g4] = *(const f32x4*)(sg + dv); zzv[dt][g4] = *(const u32x2*)(P1 + (size_t)myrow * N1 + 5120 + h * 128 + dv); }
#pragma unroll
        for (int dt = 0; dt < 4; ++dt)
#pragma unroll
            for (int g4 = 0; g4 < 4; ++g4) {
                const int dv = 32 * dt + 8 * g4 + 4 * hh;
                const f32x4 gg = ggv[dt][g4];
                const u32x2 z = zzv[dt][g4];
                const float y0 = ot[dt][4 * g4] * rstd * gg[0] * silu_f(bf_lo(z[0])), y1 = ot[dt][4 * g4 + 1] * rstd * gg[1] * silu_f(bf_hi(z[0]));
                const float y2 = ot[dt][4 * g4 + 2] * rstd * gg[2] * silu_f(bf_lo(z[1])), y3 = ot[dt][4 * g4 + 3] * rstd * gg[3] * silu_f(bf_hi(z[1]));
                u32x2 o; o[0] = cvt_pk_bf16(y0, y1); o[1] = cvt_pk_bf16(y2, y3);
                *(u32x2*)(merged + (size_t)myrow * 2048 + 1024 + h * 128 + dv) = o;
            }
    }
    __syncthreads();
}

__device__ NOINL void phase_attn(const Params* gp, int L, L8* smem, int qinst) {
    PHASE_ENTRY;
    const int j = L >> 1, tid = tidx(), lane = tid & 63;
    {
        const float* ybuf = (const float*)(p.ws + OFF_YBUF);
        const bf16_t* P1 = (const bf16_t*)(p.ws + OFF_P1);
        bf16_t* gbuf = (bf16_t*)(p.ws + OFF_GBUF);
        const float* dsk = p.s5_d + j * 1024;
        const int gs = gdim() * 512, idx0 = bidx() * 512 + tid, c8 = (idx0 & 127) * 8;
        const float4 d0 = *(const float4*)(dsk + c8), d1 = *(const float4*)(dsk + c8 + 4);
        const float dd[8] = {d0.x, d0.y, d0.z, d0.w, d1.x, d1.y, d1.z, d1.w};
        if ((gs & 127) == 0)
        for (int idx = idx0; idx < NROW * 128; idx += 3 * gs) {
            int rows[3]; float4 a0[3], a1[3], b0[3], b1[3]; u32x4v u8[3];
#pragma unroll
            for (int u = 0; u < 3; ++u) {
                const int ix = (idx + u * gs < NROW * 128) ? idx + u * gs : idx; rows[u] = ix >> 7;
                const float* y0 = ybuf + (size_t)rows[u] * 1024 + c8; const float* y1 = y0 + (size_t)NROW * 1024;
                a0[u] = *(const float4*)y0; a1[u] = *(const float4*)(y0 + 4); b0[u] = *(const float4*)y1; b1[u] = *(const float4*)(y1 + 4);
                u8[u] = *(const u32x4v*)(P1 + (size_t)rows[u] * N1 + c8);
            }
#pragma unroll
            for (int u = 0; u < 3; ++u) {
                float y[8] = {a0[u].x + b0[u].x, a0[u].y + b0[u].y, a0[u].z + b0[u].z, a0[u].w + b0[u].w, a1[u].x + b1[u].x, a1[u].y + b1[u].y, a1[u].z + b1[u].z, a1[u].w + b1[u].w};
#pragma unroll
                for (int e = 0; e < 8; ++e) { const float uv = (e & 1) ? bf_hi(u8[u][e >> 1]) : bf_lo(u8[u][e >> 1]);
                    const float v = y[e] + dd[e] * uv, z = 0.7978845608028654f * (v + 0.044715f * v * v * v);
                    const float th = 1.f - 2.f * __builtin_amdgcn_rcpf(__expf(2.f * z) + 1.f); y[e] = 0.5f * v * (1.f + th); }
                u32x4v o; o[0] = cvt_pk_bf16(y[0], y[1]); o[1] = cvt_pk_bf16(y[2], y[3]); o[2] = cvt_pk_bf16(y[4], y[5]); o[3] = cvt_pk_bf16(y[6], y[7]);
                *(u32x4v*)(gbuf + (size_t)rows[u] * 1024 + c8) = o;
            }
        }
        else
        for (int idx = idx0; idx < NROW * 128; idx += gs) {
            const int row = idx >> 7, cc = (idx & 127) * 8;
            const float* y0 = ybuf + (size_t)row * 1024 + cc; const float* y1 = y0 + (size_t)NROW * 1024;
            const float4 a0 = *(const float4*)y0, a1 = *(const float4*)(y0 + 4), b0 = *(const float4*)y1, b1 = *(const float4*)(y1 + 4);
            const float4 e0 = *(const float4*)(dsk + cc), e1 = *(const float4*)(dsk + cc + 4);
            const u32x4v u8 = *(const u32x4v*)(P1 + (size_t)row * N1 + cc);
            float y[8] = {a0.x + b0.x + e0.x * bf_lo(u8[0]), a0.y + b0.y + e0.y * bf_hi(u8[0]), a0.z + b0.z + e0.z * bf_lo(u8[1]), a0.w + b0.w + e0.w * bf_hi(u8[1]),
                          a1.x + b1.x + e1.x * bf_lo(u8[2]), a1.y + b1.y + e1.y * bf_hi(u8[2]), a1.z + b1.z + e1.z * bf_lo(u8[3]), a1.w + b1.w + e1.w * bf_hi(u8[3])};
#pragma unroll
            for (int e = 0; e < 8; ++e) { const float v = y[e], z = 0.7978845608028654f * (v + 0.044715f * v * v * v);
                const float th = 1.f - 2.f * __builtin_amdgcn_rcpf(__expf(2.f * z) + 1.f); y[e] = 0.5f * v * (1.f + th); }
            u32x4v o; o[0] = cvt_pk_bf16(y[0], y[1]); o[1] = cvt_pk_bf16(y[2], y[3]); o[2] = cvt_pk_bf16(y[4], y[5]); o[3] = cvt_pk_bf16(y[6], y[7]);
            *(u32x4v*)(gbuf + (size_t)row * 1024 + cc) = o;
        }
    }
    const float* lv = p.da_lam + j * 256;
    const float s01 = wave_sum(lv[lane] * lv[64 + lane], lane), s23 = wave_sum(lv[128 + lane] * lv[192 + lane], lane);
    const float lam_init = 0.8f - 0.6f * expf(-0.3f * (float)L);
    const float lam = expf(s01) - expf(s23) + lam_init;
    {
        unsigned* cnt = (unsigned*)(p.ws + OFF_CNT);
        int y = (int)(xb_xcc_id() & 7u), tried = 0;
        for (;;) {
            const int idx = claim_item(cnt, qinst, 72, y, tried, smem);
            if (idx < 0) break;
            int bh, qb, isctx;
            if (idx < 64) { bh = y * 4 + (idx >> 4); qb = idx & 15; isctx = 0; }
            else { const int k = idx - 64; bh = y * 4 + (k >> 1); qb = k & 1; isctx = 1; }
            attn_item(p, L, bh >> 3, bh & 7, qb, isctx, lam, lam_init, smem);
        }
    }
}

__device__ NOINL void phase_gla_pre(const Params* gp, int L, L8* smem) {
    PHASE_ENTRY;
    const int j = L >> 1, tid = tidx(), col = tid & 255, half = tid >> 8;
    const bf16_t* P1 = (const bf16_t*)(p.ws + OFF_P1);
    const float* rbuf = (const float*)(p.ws + OFF_RBUF);
    bf16_t* qd = (bf16_t*)(p.ws + OFF_QD); bf16_t* pg = (bf16_t*)(p.ws + OFF_KD); bf16_t* ket = (bf16_t*)(p.ws + OFF_KET);
    float* dec = (float*)(p.ws + OFF_DEC);
    LB* Qs = (LB*)(smem + 8192); LB* Ks = (LB*)(smem + 8192 + 33792);
    const int wv = tid >> 6, n16 = tid & 15, q4 = (tid >> 4) & 3;
    LF* tot = (LF*)smem + 1024;
    LF* Lg = (LF*)(smem + 8192 + 2 * 33792);
    for (int it = bidx(); it < 1152; it += gdim()) {
        const int c = it >> 3, hd = (it >> 1) & 3, d = it & 1, row0 = c * 64;
        __syncthreads();
        bf16_t qraw[32], kraw[32];
#pragma unroll
        for (int tt = 0; tt < 32; ++tt) { const size_t o_ = (size_t)(row0 + half * 32 + tt) * N1 + hd * 256 + col; qraw[tt] = P1[o_]; kraw[tt] = P1[o_ + 1024]; }
        {
            bf16x8 Af[4], Bw[2];
#pragma unroll
            for (int mt = 0; mt < 4; ++mt) {
                float4 x0 = make_float4(0.f, 0.f, 0.f, 0.f), x1 = x0;
                if (q4 < 2) { const float* rp = rbuf + (size_t)(row0 + 16 * mt + n16) * 32 + d * 16 + 8 * q4; x0 = *(const float4*)rp; x1 = *(const float4*)(rp + 4); }
                Af[mt] = pack8(x0.x, x0.y, x0.z, x0.w, x1.x, x1.y, x1.z, x1.w);
            }
#pragma unroll
            for (int nn = 0; nn < 2; ++nn) {
                float wv8[8];
#pragma unroll
                for (int e = 0; e < 8; ++e) wv8[e] = (q4 < 2) ? p.gla_wa2[((size_t)(j * 2 + d) * 16 + 8 * q4 + e) * 1024 + hd * 256 + 16 * (2 * wv + nn) + n16] : 0.f;
                Bw[nn] = pack8(wv8[0], wv8[1], wv8[2], wv8[3], wv8[4], wv8[5], wv8[6], wv8[7]);
            }
#pragma unroll
            for (int mt = 0; mt < 4; ++mt)
#pragma unroll
                for (int nn = 0; nn < 2; ++nn) {
                    f32x4 acc = {0.f, 0.f, 0.f, 0.f};
                    acc = mfma16(Af[mt], Bw[nn], acc);
#pragma unroll
                    for (int i = 0; i < 4; ++i) Lg[(16 * mt + 4 * q4 + i) * 260 + 16 * (2 * wv + nn) + n16] = acc[i];
                }
        }
        const float bias = p.gla_ba[(j * 2 + d) * 1024 + hd * 256 + col];
        __syncthreads();
        float la[32]; float run = 0.f;
#pragma unroll
        for (int tt = 0; tt < 32; ++tt) {
            const int t = half * 32 + tt; const float lg = bias + Lg[t * 260 + col];
            la[tt] = (fminf(lg, 0.f) - __logf(1.f + __expf(-fabsf(lg)))) * (1.f / 16.f);
            run += la[tt];
        }
        tot[half * 256 + col] = run;
        __syncthreads();
        const float tot0 = tot[col], tot1 = tot[256 + col], bend = tot0 + tot1;
        float bcum[32];
        if (d == 0) { float a = half ? tot0 : 0.f;
#pragma unroll
            for (int tt = 0; tt < 32; ++tt) { a += la[tt]; bcum[tt] = a; } }
        else { float a = half ? 0.f : tot1;
#pragma unroll
            for (int tt = 31; tt >= 0; --tt) { a += la[tt]; bcum[tt] = a; } }
        const size_t gcol = hd * 256 + col;
        unsigned kev[16];
#pragma unroll
        for (int tp = 0; tp < 16; ++tp) {
            float ke2[2];
#pragma unroll
            for (int e = 0; e < 2; ++e) {
                const int tt = 2 * tp + e, row = row0 + half * 32 + tt;
                const float qv = bf2f(qraw[tt]), kv = bf2f(kraw[tt]);
                const bf16_t qb_ = f2bf(qv * 0.0625f * __expf(bcum[tt])), kb_ = f2bf(kv * __expf(-bcum[tt]));
                qd[((size_t)d * NROW + row) * 1024 + gcol] = qb_;
                Qs[(half * 32 + tt) * 264 + col] = qb_; Ks[(half * 32 + tt) * 264 + col] = kb_;
                ke2[e] = kv * __expf(bend - bcum[tt]);
            }
            kev[tp] = cvt_pk_bf16(ke2[0], ke2[1]);
        }
        bf16_t* kp = ket + (((size_t)d * 144 + c) * 1024 + gcol) * 64 + half * 32;
#pragma unroll
        for (int e = 0; e < 4; ++e) { u32x4v o = {kev[4 * e], kev[4 * e + 1], kev[4 * e + 2], kev[4 * e + 3]}; *(u32x4v*)(kp + 8 * e) = o; }
        if (half == 0) dec[((size_t)d * 144 + c) * 1024 + gcol] = __expf(bend);
        __syncthreads();
        {
            const int mt = wv >> 1, nb = 2 * (wv & 1);
            f32x4 sc[2] = {(f32x4){0.f, 0.f, 0.f, 0.f}, (f32x4){0.f, 0.f, 0.f, 0.f}};
#pragma unroll
            for (int ks = 0; ks < 8; ++ks) {
                const bf16x8 A = LV(const bf16x8, Ks + (16 * mt + n16) * 264 + 32 * ks + 8 * q4);
#pragma unroll
                for (int nn = 0; nn < 2; ++nn) { const bf16x8 B = LV(const bf16x8, Qs + (16 * (nb + nn) + n16) * 264 + 32 * ks + 8 * q4); sc[nn] = mfma16(A, B, sc[nn]); }
            }
            bf16_t* pp = pg + (((size_t)d * 144 + c) * 4 + hd) * 4096;
#pragma unroll
            for (int nn = 0; nn < 2; ++nn) {
                const int t = 16 * (nb + nn) + n16, s0 = 16 * mt + 4 * q4;
                float v[4];
#pragma unroll
                for (int i = 0; i < 4; ++i) { const int s = s0 + i; const bool keep = d ? (t <= s) : (t >= s); v[i] = keep ? sc[nn][i] : 0.f; }
                u32x2 o; o[0] = cvt_pk_bf16(v[0], v[1]); o[1] = cvt_pk_bf16(v[2], v[3]);
                *(u32x2*)(pp + t * 64 + s0) = o;
            }
        }
    }
}

__device__ NOINL void phase_gla(const Params* gp, int L, L8* smem, int qinst) {
    PHASE_ENTRY;
    const int tid = tidx(), w = tid >> 6, lane = tid & 63, n16 = lane & 15, q4 = lane >> 4;
    const bf16_t* qd = (const bf16_t*)(p.ws + OFF_QD); const bf16_t* pg = (const bf16_t*)(p.ws + OFF_KD); const bf16_t* ket = (const bf16_t*)(p.ws + OFF_KET);
    const bf16_t* vTg = (const bf16_t*)(p.ws + OFF_VT);
    const float* decg = (const float*)(p.ws + OFF_DEC);
    float* obuf = (float*)(p.ws + OFF_OBUF);
    L8* Qd = smem; L8* Kd = smem + 33792; L8* KeT = smem + 67584; L8* VTs = smem + 104448;
    L8* STs = smem + 113664; L8* Ps = smem + 147456; LF* decl = (LF*)(smem + 156672);
    const int r8 = tid >> 3, s8 = tid & 7, dk2 = tid >> 1, sg2 = tid & 1;
    unsigned* cnt = (unsigned*)(p.ws + OFF_CNT);
    int qy = (int)(xb_xcc_id() & 7u), qtried = 0;
    for (;;) {
        const int qidx = claim_item(cnt, qinst, 32, qy, qtried, smem);
        if (qidx < 0) break;
        const int stream = qy * 4 + (qidx >> 3), dvs = qidx & 7;
        const int b = stream >> 3, hd = (stream >> 1) & 3, d = stream & 1;
        f32x4 S[2][4];
#pragma unroll
        for (int mt = 0; mt < 2; ++mt)
#pragma unroll
            for (int nt = 0; nt < 4; ++nt) S[mt][nt] = (f32x4){0.f, 0.f, 0.f, 0.f};
        struct GlaRegs { u32x4v rq[4], rp, re[4], rv; float rdec; };
        GlaRegs R0, R1; R0.rdec = 0.f; R1.rdec = 0.f;
#define GLA_CHUNK(cq_, c_, no_) const int ic_ = (cq_) < 4, ix_ = ic_ ? (cq_) : (cq_) - 4, ns_ = ic_ ? 4 : 32, cs_ = d ? (ns_ - 1 - ix_) : ix_; \
        const int c_ = ic_ ? (128 + b * 4 + cs_) : (b * 32 + cs_); const bool no_ = !(ic_ && L == 3)
#define GLA_LOAD(R_, cq_) do { GLA_CHUNK(cq_, cc_, noo_); const int rr0_ = cc_ * 64; \
        if (noo_) { const bf16_t* src = qd + ((size_t)d * NROW + rr0_ + r8) * 1024 + hd * 256 + s8 * 8; _Pragma("unroll") for (int e = 0; e < 4; ++e) R_.rq[e] = *(const u32x4v*)(src + 64 * e); } \
        if (noo_) R_.rp = *(const u32x4v*)(pg + (((size_t)d * 144 + cc_) * 4 + hd) * 4096 + r8 * 64 + s8 * 8); \
        { const bf16_t* src = ket + (((size_t)d * 144 + cc_) * 1024 + hd * 256 + 32 * w + n16) * 64 + 8 * q4; _Pragma("unroll") for (int e = 0; e < 4; ++e) R_.re[e] = *(const u32x4v*)(src + (e >> 1) * 1024 + (e & 1) * 32); } \
        R_.rv = *(const u32x4v*)(vTg + ((size_t)cc_ * 2048 + hd * 512 + dvs * 64 + r8) * 64 + s8 * 8); \
        if (tid < 256) R_.rdec = decg[((size_t)d * 144 + cc_) * 1024 + hd * 256 + tid]; } while (0)
        GLA_LOAD(R0, 0); GLA_LOAD(R1, 1);
#ifdef GLA_PROBE
        long long a01 = 0, a12 = 0, a23 = 0, a30 = 0, tprev = clock64();
#endif
        auto chunk_step = [&](GlaRegs& R, const int cq) __attribute__((always_inline)) {
            GLA_CHUNK(cq, c, need_o);
            const int row0 = c * 64;
#ifdef GLA_PROBE
            const long long t0 = clock64(); a30 += t0 - tprev;
#endif
            __syncthreads();
#pragma unroll
            for (int mt = 0; mt < 2; ++mt)
#pragma unroll
                for (int nt = 0; nt < 4; ++nt) { u32x2 o; o[0] = cvt_pk_bf16(S[mt][nt][0], S[mt][nt][1]); o[1] = cvt_pk_bf16(S[mt][nt][2], S[mt][nt][3]);
                    LV(u32x2, STs + (16 * nt + n16) * 528 + (32 * w + 16 * mt + 4 * q4) * 2) = o; }
            if (need_o) {
#pragma unroll
                for (int e = 0; e < 4; ++e) LV(u32x4v, Qd + r8 * 528 + s8 * 16 + 128 * e) = R.rq[e]; }
            if (need_o) LV(u32x4v, Ps + r8 * 144 + s8 * 16) = R.rp;
            LV(u32x4v, VTs + r8 * 144 + s8 * 16) = R.rv;
            if (tid < 256) decl[tid] = R.rdec;
            __syncthreads();
#ifdef GLA_PROBE
            const long long t1 = clock64(); a01 += t1 - t0;
#endif
            if (need_o) {
                const int mt = w >> 1, nb = 2 * (w & 1);
                {
                    f32x4 oa[2] = {(f32x4){0.f, 0.f, 0.f, 0.f}, (f32x4){0.f, 0.f, 0.f, 0.f}};
#pragma unroll
                    for (int ks = 0; ks < 2; ++ks) {
                        const bf16x8 A = LV(const bf16x8, Ps + (16 * mt + n16) * 144 + (32 * ks + 8 * q4) * 2);
#pragma unroll
                        for (int nn = 0; nn < 2; ++nn) { const bf16x8 B = LV(const bf16x8, VTs + (16 * (nb + nn) + n16) * 144 + (32 * ks + 8 * q4) * 2); oa[nn] = mfma16(A, B, oa[nn]); }
                    }
#pragma unroll
                    for (int ks = 0; ks < 8; ++ks) {
                        const bf16x8 A = LV(const bf16x8, Qd + (16 * mt + n16) * 528 + (32 * ks + 8 * q4) * 2);
#pragma unroll
                        for (int nn = 0; nn < 2; ++nn) { const bf16x8 B = LV(const bf16x8, STs + (16 * (nb + nn) + n16) * 528 + (32 * ks + 8 * q4) * 2); oa[nn] = mfma16(A, B, oa[nn]); }
                    }
#pragma unroll
                    for (int nn = 0; nn < 2; ++nn)
#pragma unroll
                        for (int i = 0; i < 4; ++i)
                            obuf[((size_t)d * NROW + row0 + 16 * mt + 4 * q4 + i) * 2048 + hd * 512 + dvs * 64 + 16 * (nb + nn) + n16] = oa[nn][i];
                }
            }
#ifdef GLA_PROBE
            const long long t2 = clock64(); a12 += t2 - t1;
#endif
#pragma unroll
            for (int mt = 0; mt < 2; ++mt) { const f32x4 dv4 = LV(const f32x4, decl + 32 * w + 16 * mt + 4 * q4);
#pragma unroll
                for (int nt = 0; nt < 4; ++nt) S[mt][nt] *= dv4; }
#pragma unroll
            for (int ks = 0; ks < 2; ++ks) {
                bf16x8 A[2];
#pragma unroll
                for (int mt = 0; mt < 2; ++mt) A[mt] = __builtin_bit_cast(bf16x8, R.re[2 * mt + ks]);
#pragma unroll
                for (int nt = 0; nt < 4; ++nt) { const bf16x8 B = LV(const bf16x8, VTs + (16 * nt + n16) * 144 + (32 * ks + 8 * q4) * 2);
#pragma unroll
                    for (int mt = 0; mt < 2; ++mt) S[mt][nt] = mfma16(A[mt], B, S[mt][nt]); }
            }
            if (cq + 2 < 36) GLA_LOAD(R, cq + 2);
#ifdef GLA_PROBE
            asm volatile("" :: "v"(S[0][0][0]), "v"(S[1][3][3]));
            tprev = clock64(); a23 += tprev - t2;
#endif
        };
        for (int cq = 0; cq < 36; cq += 2) { chunk_step(R0, cq); chunk_step(R1, cq + 1); }
#ifdef GLA_PROBE
        if (bidx() == 0 && tid == 0 && L == 1) { float* dbg = (float*)(p.ws + OFF_DBG); dbg[0] = (float)a01 / 36.f; dbg[1] = (float)a12 / 36.f; dbg[2] = (float)a23 / 36.f; dbg[3] = (float)a30 / 36.f; }
#endif
#undef GLA_LOAD
#undef GLA_CHUNK
    }
}

__device__ NOINL void phase_gla_finish(const Params* gp, int L, L8* smem) {
    PHASE_ENTRY;
    const int j = L >> 1, wave = tidx() >> 6, lane = tidx() & 63;
    const float* obuf = (const float*)(p.ws + OFF_OBUF);
    const bf16_t* P1 = (const bf16_t*)(p.ws + OFF_P1);
    bf16_t* merged = (bf16_t*)(p.ws + OFF_MERGED);
    const float* gn = p.gla_norm_g + j * 512;
    const int nrows = (L == 3) ? NLAT : NROW;
    const float4 g0 = *(const float4*)(gn + lane * 8), g1 = *(const float4*)(gn + lane * 8 + 4);
    const float gg[8] = {g0.x, g0.y, g0.z, g0.w, g1.x, g1.y, g1.z, g1.w};
    const int stride = gdim() * 8, total = nrows * 4;
    for (int it = bidx() * 8 + wave; it < total; it += 2 * stride) {
        int itx[2]; itx[0] = it; itx[1] = (it + stride < total) ? it + stride : it;
        float4 a0[2], a1[2], b0[2], b1[2]; u32x4v z8[2];
#pragma unroll
        for (int u = 0; u < 2; ++u) {
            const int row = itx[u] >> 2, c0 = (itx[u] & 3) * 512 + lane * 8;
            const float* o0 = obuf + (size_t)row * 2048 + c0; const float* o1 = o0 + (size_t)NROW * 2048;
            a0[u] = *(const float4*)o0; a1[u] = *(const float4*)(o0 + 4); b0[u] = *(const float4*)o1; b1[u] = *(const float4*)(o1 + 4);
            z8[u] = *(const u32x4v*)(P1 + (size_t)row * N1 + 4096 + c0);
        }
#pragma unroll
        for (int u = 0; u < 2; ++u) {
            const int row = itx[u] >> 2, c0 = (itx[u] & 3) * 512 + lane * 8;
            float v[8] = {a0[u].x + b0[u].x, a0[u].y + b0[u].y, a0[u].z + b0[u].z, a0[u].w + b0[u].w, a1[u].x + b1[u].x, a1[u].y + b1[u].y, a1[u].z + b1[u].z, a1[u].w + b1[u].w};
            float ss = 0.f;
#pragma unroll
            for (int e = 0; e < 8; ++e) ss += v[e] * v[e];
            ss = wave_sum(ss, lane);
            const float rstd = rsqrtf(ss * (1.f / 512.f) + 1e-6f);
            float y[8];
#pragma unroll
            for (int e = 0; e < 8; ++e) { const float z = (e & 1) ? bf_hi(z8[u][e >> 1]) : bf_lo(z8[u][e >> 1]); y[e] = v[e] * rstd * gg[e] * silu_f(z); }
            u32x4v o; o[0] = cvt_pk_bf16(y[0], y[1]); o[1] = cvt_pk_bf16(y[2], y[3]); o[2] = cvt_pk_bf16(y[4], y[5]); o[3] = cvt_pk_bf16(y[6], y[7]);
            *(u32x4v*)(merged + (size_t)row * 2048 + c0) = o;
        }
    }
}

constexpr int N_PHASES = 25;
__device__ NOINL void phase_gemm1(const Params* gp, int L, L8* smem) {
    PHASE_ENTRY;
    const int odd = L & 1;
    EpiIn E{(bf16_t*)(p.ws + OFF_P1), (bf16_t*)(p.ws + OFF_VT), (float*)(p.ws + OFF_RBUF), odd, smem + 131072};
    run_gemm(smem, (const bf16_t*)(p.ws + OFF_H), (const bf16_t*)(p.ws + OFF_WTIN + (size_t)L * SZ_WTIN1), NROW, odd ? N1P : N1, 2048, E);
    if (L < 3) { const int nun = 36 * (odd ? 25 : 24), spare0 = nun % gdim(); if (spare0 > 0 && bidx() >= spare0) aux_layer(p, L + 1, bidx() - spare0, gdim() - spare0, smem, 2); else if (spare0 == 0) aux_layer(p, L + 1, bidx(), gdim(), smem, 2); }
}
__device__ NOINL void phase_glu(const Params* gp, int L, L8* smem) {
    PHASE_ENTRY;
    EpiGlu E{(const bf16_t*)(p.ws + OFF_GBUF), (const bf16_t*)(p.ws + OFF_P1), (bf16_t*)(p.ws + OFF_MERGED)};
    run_gemm(smem, (const bf16_t*)(p.ws + OFF_GBUF), (const bf16_t*)(p.ws + OFF_WTGLU + (size_t)(L >> 1) * SZ_WTGLU1), NROW, 1024, 1024, E);
}
__device__ NOINL void phase_gemm2(const Params* gp, int L, L8* smem) {
    PHASE_ENTRY;
    float* xbuf = (float*)(p.ws + OFF_XBUF);
    EpiOut E{L == 0 ? p.x : xbuf, L == 0 ? p.ctx : xbuf + (size_t)NLAT * 2048, L == 3 ? p.out : xbuf, xbuf + (size_t)NLAT * 2048, (const float*)(p.ws + OFF_MOD) + (size_t)L * 5 * 6144};
    run_gemm(smem, (const bf16_t*)(p.ws + OFF_MERGED), (const bf16_t*)(p.ws + OFF_WTOUT + (size_t)L * SZ_WTOUT1), L == 3 ? NLAT : NROW, 2048, 2048, E);
    if (L < 3) { const int spare0 = 288 - gdim(); if (spare0 >= 0 && spare0 < gdim() && bidx() >= spare0) aux_layer(p, L + 1, bidx() - spare0, gdim() - spare0, smem, 1); else if (spare0 < 0 || spare0 >= gdim()) aux_layer(p, L + 1, bidx(), gdim(), smem, 1); }
}
#ifndef PROBE_MASK
#define PROBE_MASK 0
#endif
__device__ __forceinline__ void run_phase(const Params* gp, int ph, L8* smem) {
    const int mask = gp->ph_lo;
#define NREP(k) (((mask >> (k)) & 1) + 1)
    if (ph == 0) { for (int r = 0; r < NREP(0); ++r) phase_prologue(gp, 0, smem); return; }
    const int L = (ph - 1) / 6, s = (ph - 1) % 6, odd = L & 1;
    if (s == 0) { for (int r = 0; r < NREP(1); ++r) phase_norm(gp, L, smem); }
    else if (s == 1) { for (int r = 0; r < NREP(2); ++r) phase_gemm1(gp, L, smem); }
    else if (s == 2) { if (odd) { for (int r = 0; r < NREP(3); ++r) phase_gla_pre(gp, L, smem); } else { for (int r = 0; r < NREP(4); ++r) phase_s5(gp, L, smem, r == 0); } }
    else if (s == 3) { if (odd) { for (int r = 0; r < NREP(5); ++r) phase_gla(gp, L, smem, L + 4 * r); } else { for (int r = 0; r < NREP(6); ++r) phase_attn(gp, L, smem, L + 4 * r); } }
    else if (s == 4) { if (odd) { for (int r = 0; r < NREP(7); ++r) phase_gla_finish(gp, L, smem); } else { for (int r = 0; r < NREP(8); ++r) phase_glu(gp, L, smem); } }
    else { const int n = (L == 0 || L == 3) ? NREP(9) : 1; for (int r = 0; r < n; ++r) phase_gemm2(gp, L, smem); }
#undef NREP
}

__global__ void __launch_bounds__(512) hybrid_fwd_megakernel(Params p) {
    extern __shared__ __attribute__((aligned(16))) unsigned char smem_raw[];
    L8* smem = (L8*)smem_raw;
    cg::grid_group grid = cg::this_grid();
    const Params* gp = &p;
    unsigned* bar = (unsigned*)(p.ws + OFF_BAR);
    if (blockIdx.x == 0) for (int i = threadIdx.x; i < XCD_BAR_WORDS; i += 512) __hip_atomic_store(bar + i, 0u, __ATOMIC_RELAXED, __HIP_MEMORY_SCOPE_AGENT);
    if (blockIdx.x == 0) for (int i = threadIdx.x; i < 8 * 8 * 16; i += 512) __hip_atomic_store((unsigned*)(p.ws + OFF_CNT) + i, 0u, __ATOMIC_RELAXED, __HIP_MEMORY_SCOPE_AGENT);
    volatile LAS unsigned* st = (volatile LAS unsigned*)(smem + LDS_BYTES - 16);
    if (threadIdx.x < 4) st[threadIdx.x] = 0u;
    __syncthreads();
    run_phase(gp, 0, smem);
    grid.sync();
    XcdBarrier xb = xcd_barrier_post(bar, st);
    const unsigned xbx = xb.x, stw = (unsigned)(unsigned long long)st;
    for (int ph = 1; ph < p.ph_hi; ++ph) {
        if (ph > 1) { unsigned* b2 = bar; unsigned x2 = xbx; unsigned st2 = stw; asm volatile("" : "+s"(b2), "+s"(x2), "+s"(st2)); xb.bar = b2; xb.x = x2; xb.st = (volatile LAS unsigned*)(unsigned long long)st2; xcd_barrier(xb); }
        run_phase(gp, ph, smem);
    }
#ifdef DBG_A
    xcd_barrier(xb);
    {
        const float* dbg = (const float*)(p.ws + OFF_DBG);
        const float va = dbg[DBG_A], vb = dbg[DBG_B] * 0.01f;
        if (blockIdx.x == 0 && threadIdx.x == 0) p.out[0] = va;
        for (int i = blockIdx.x * 512 + threadIdx.x; i < (1 << 20); i += gridDim.x * 512) p.out[(1 << 20) + i] += vb;
    }
#endif
}

extern "C" void kernel_launch(void* const* d_in, const int* in_sizes, int n_in, void* d_out, int out_size, void* d_ws, size_t ws_size, hipStream_t stream) {
    static int grid_blocks = 0;
    if (grid_blocks == 0) {
        if (n_in != 28 || ws_size < WS_END) { fprintf(stderr, "kernel_launch: expected 28 inputs and >= %zu bytes of workspace; got %d, %zu\n", (size_t)WS_END, n_in, ws_size); grid_blocks = -1; return; }
        int dev = 0, cus = 0, per_cu = 0;
        hipGetDevice(&dev);
        hipDeviceGetAttribute(&cus, hipDeviceAttributeMultiprocessorCount, dev);
        if (hipFuncSetAttribute((const void*)hybrid_fwd_megakernel, hipFuncAttributeMaxDynamicSharedMemorySize, LDS_BYTES) != hipSuccess) { fprintf(stderr, "kernel_launch: hipFuncSetAttribute failed\n"); grid_blocks = -1; return; }
        if (hipOccupancyMaxActiveBlocksPerMultiprocessor(&per_cu, (const void*)hybrid_fwd_megakernel, 512, LDS_BYTES) != hipSuccess || per_cu < 1) { fprintf(stderr, "kernel_launch: occupancy query gave %d\n", per_cu); per_cu = 1; }
        (void)hipGetLastError();
        grid_blocks = cus * per_cu;
    }
    if (grid_blocks < 0) return;
    Params p{};
    const float** ip = (const float**)&p;
    for (int i = 0; i < 28; ++i) ip[i] = (const float*)d_in[i];
    p.out = (float*)d_out; p.ws = (unsigned char*)d_ws; p.ph_lo = PROBE_MASK; p.ph_hi = N_PHASES;
    void* args[] = {&p};
    hipError_t e = hipLaunchCooperativeKernel((const void*)hybrid_fwd_megakernel, dim3(grid_blocks), dim3(512), args, LDS_BYTES, stream);
    if (e != hipSuccess) fprintf(stderr, "cooperative launch failed: %s (grid %d)\n", hipGetErrorString(e), grid_blocks);
}
```
